# Optimizing an MI355X kernel written in HIP

```python
import functools
import jax, jax.numpy as jnp
from jax import lax
import numpy as np

D_MODEL = 4096
BATCH = 4
SEQ = 2048
DEPTH = 1
DEC_BATCH = 128
DEC_SEQ = 4
PAST_LEN = 16384
PAGE_SIZE = 128

D_MIX = D_MODEL
GLA_WIDTH = D_MIX // 2
SSD_WIDTH = D_MIX - GLA_WIDTH
GLA_HEADS = 4
GLA_DV = GLA_WIDTH // GLA_HEADS
GLA_DK = GLA_DV // 2
GLA_QK = GLA_HEADS * GLA_DK
GATE_RANK = 16
GATE_NORM = 16.0
SSD_HEAD_DIM = 64
SSD_HEADS = SSD_WIDTH // SSD_HEAD_DIM
SSD_GROUPS = 8
HEADS_PER_GROUP = SSD_HEADS // SSD_GROUPS
D_STATE = 128
CONV_W = 4
CONV_DIM = SSD_WIDTH + 2 * SSD_GROUPS * D_STATE
D_FF = 4 * D_MODEL
N_META = 16
CHUNK = 64
SPLIT_SIZES = (GLA_QK, GLA_QK, GLA_WIDTH, GLA_WIDTH, GATE_RANK, SSD_WIDTH, CONV_DIM, SSD_HEADS)
D_IN = GLA_QK * 2 + GLA_WIDTH * 2 + GATE_RANK + SSD_WIDTH + CONV_DIM + SSD_HEADS
ALPHA = (2.0 * DEPTH) ** 0.25
BETA = (8.0 * DEPTH) ** -0.25
EPS = 1e-5

kernel_name = "hymba_gla_ssd_deepnorm_step"


def _layer_norm(x, g, b):
    xf = x.astype(jnp.float32)
    mu = jnp.mean(xf, axis=-1, keepdims=True)
    var = jnp.mean(jnp.square(xf - mu), axis=-1, keepdims=True)
    return ((xf - mu) * lax.rsqrt(var + EPS) * g.astype(jnp.float32) + b.astype(jnp.float32)).astype(x.dtype)


def _rms(xf):
    return xf * lax.rsqrt(jnp.mean(jnp.square(xf), axis=-1, keepdims=True) + EPS)


def _gla_chunk(S, q, k, v, g):
    T = q.shape[1]
    b = jnp.cumsum(g, axis=1)
    mask = jnp.tril(jnp.ones((T, T), dtype=bool))
    diff = b[:, :, None] - b[:, None, :]
    decay = jnp.exp(jnp.where(mask[None, :, :, None, None], diff, -jnp.inf))
    scores = jnp.einsum('bthk,bshk,btshk->bhts', q, k, decay)
    o = jnp.einsum('bhts,bshv->bthv', scores, v) + jnp.einsum('bthk,bhkv->bthv', q * jnp.exp(b), S)
    b_last = b[:, -1]
    S_new = jnp.exp(b_last)[..., None] * S + jnp.einsum(
        'bshk,bshv->bhkv', k * jnp.exp(b_last[:, None] - b), v)
    return S_new, o


def _ssd_chunk(h, x, bm, cm, dt, a):
    T = x.shape[1]
    cum = jnp.cumsum(dt * a, axis=1)
    mask = jnp.tril(jnp.ones((T, T), dtype=bool))
    lmat = jnp.exp(jnp.where(mask[None, :, :, None, None], cum[:, :, None] - cum[:, None], -jnp.inf))
    cb = jnp.einsum('btgn,bsgn->btsg', cm, bm)
    y = jnp.einsum('btsg,btsgj,bsgj,bsgjp->btgjp', cb, lmat, dt, x)
    y = y + jnp.einsum('btgn,bgjpn->btgjp', cm, h) * jnp.exp(cum)[..., None]
    c_last = cum[:, -1]
    h_new = jnp.exp(c_last)[..., None, None] * h + jnp.einsum(
        'bsgn,bsgj,bsgjp->bgjpn', bm, jnp.exp(c_last[:, None] - cum) * dt, x)
    return h_new, y


def _run_chunked(step, state, xs, lead):
    T = xs[0].shape[1]
    outs = []
    if lead > 0:
        state, o = step(state, *[a[:, :lead] for a in xs])
        outs.append(o)
    n_full = (T - lead) // CHUNK
    if n_full > 0:
        blocks = tuple(
            jnp.moveaxis(a[:, lead:lead + n_full * CHUNK].reshape(a.shape[0], n_full, CHUNK, *a.shape[2:]), 1, 0)
            for a in xs)
        state, o = lax.scan(lambda s, blk: step(s, *blk), state, blocks)
        o = jnp.moveaxis(o, 0, 1)
        outs.append(o.reshape(o.shape[0], n_full * CHUNK, *o.shape[3:]))
    start = lead + n_full * CHUNK
    if start < T:
        state, o = step(state, *[a[:, start:] for a in xs])
        outs.append(o)
    return state, jnp.concatenate(outs, axis=1)


def _layer(x, gla_s, ssm_h, conv_buf, lead, w_in, w_gk_up, b_gk, gla_norm_w, conv_w, conv_b,
           dt_bias, a_log, d_skip, ssd_norm_w, w_out, ln1_g, ln1_b, w_up, w_down, ln2_g, ln2_b):
    f32 = jnp.float32
    B, T, _ = x.shape
    u = x @ w_in
    pts, acc = [], 0
    for s in SPLIT_SIZES[:-1]:
        acc += s
        pts.append(acc)
    q, k, v, r, gk_low, z, xbc, dt_raw = jnp.split(u, pts, axis=-1)

    qh = q.reshape(B, T, GLA_HEADS, GLA_DK).astype(f32) * (GLA_DK ** -0.5)
    kh = k.reshape(B, T, GLA_HEADS, GLA_DK).astype(f32)
    vh = v.reshape(B, T, GLA_HEADS, GLA_DV).astype(f32)
    g = jax.nn.log_sigmoid((gk_low @ w_gk_up + b_gk).astype(f32)) / GATE_NORM
    g = g.reshape(B, T, GLA_HEADS, GLA_DK)
    gla_new, o = _run_chunked(_gla_chunk, gla_s.astype(f32), (qh, kh, vh, g), lead)
    o = _rms(o) * gla_norm_w.astype(f32) * jax.nn.silu(r.reshape(B, T, GLA_HEADS, GLA_DV).astype(f32))
    o = o.reshape(B, T, GLA_WIDTH)

    xbc_full = jnp.concatenate([conv_buf.astype(xbc.dtype), xbc], axis=1)
    conv_new = xbc_full[:, -(CONV_W - 1):]
    xc = lax.conv_general_dilated(xbc_full, conv_w[:, None, :].astype(xbc.dtype), window_strides=(1,),
                                  padding='VALID', dimension_numbers=('NWC', 'WIO', 'NWC'),
                                  feature_group_count=CONV_DIM)
    xc = jax.nn.silu((xc + conv_b).astype(f32))
    xs, bm, cm = jnp.split(xc, [SSD_WIDTH, SSD_WIDTH + SSD_GROUPS * D_STATE], axis=-1)
    xs = xs.reshape(B, T, SSD_GROUPS, HEADS_PER_GROUP, SSD_HEAD_DIM)
    bm = bm.reshape(B, T, SSD_GROUPS, D_STATE)
    cm = cm.reshape(B, T, SSD_GROUPS, D_STATE)
    dt = jax.nn.softplus(dt_raw.astype(f32) + dt_bias.astype(f32)).reshape(B, T, SSD_GROUPS, HEADS_PER_GROUP)
    a = -jnp.exp(a_log.astype(f32)).reshape(SSD_GROUPS, HEADS_PER_GROUP)
    h0 = ssm_h.astype(f32).reshape(B, SSD_GROUPS, HEADS_PER_GROUP, SSD_HEAD_DIM, D_STATE)
    ssm_new, y = _run_chunked(functools.partial(_ssd_chunk, a=a), h0, (xs, bm, cm, dt), lead)
    y = y + d_skip.astype(f32).reshape(SSD_GROUPS, HEADS_PER_GROUP)[..., None] * xs
    y = y.reshape(B, T, SSD_WIDTH) * jax.nn.silu(z.astype(f32))
    y = _rms(y.reshape(B, T, SSD_GROUPS, SSD_WIDTH // SSD_GROUPS)).reshape(B, T, SSD_WIDTH)
    y = y * ssd_norm_w.astype(f32)

    mix = jnp.concatenate([o, y], axis=-1).astype(x.dtype) @ w_out
    h = _layer_norm(ALPHA * x + mix, ln1_g, ln1_b)
    f = jnp.square(jax.nn.relu(h @ w_up)) @ w_down
    out = _layer_norm(ALPHA * h + f, ln2_g, ln2_b)
    return (out, gla_new.astype(x.dtype),
            ssm_new.reshape(B, SSD_HEADS, SSD_HEAD_DIM, D_STATE).astype(x.dtype), conv_new.astype(x.dtype))


def setup_inputs(seed: int = 0) -> dict:
    key = jax.random.key(seed)
    ks = jax.random.split(key, 26)
    nrm = jax.random.normal
    f32 = jnp.float32
    dt = jnp.exp(jax.random.uniform(ks[12], (DEPTH, SSD_HEADS), f32) * (np.log(0.1) - np.log(0.001)) + np.log(0.001))
    return {
        "x_prompt": nrm(ks[0], (BATCH, SEQ, D_MODEL), f32),
        "x_sample": nrm(ks[1], (DEC_BATCH, DEC_SEQ, D_MODEL), f32),
        "state_gla": 0.5 * nrm(ks[2], (DEPTH, DEC_BATCH, GLA_HEADS, GLA_DK, GLA_DV), f32),
        "state_ssm": 0.1 * nrm(ks[3], (DEPTH, DEC_BATCH, SSD_HEADS, SSD_HEAD_DIM, D_STATE), f32),
        "state_conv": nrm(ks[4], (DEPTH, DEC_BATCH, CONV_W - 1, CONV_DIM), f32),
        "meta_tokens": nrm(ks[5], (N_META, D_MODEL), f32),
        "w_in": nrm(ks[6], (DEPTH, D_MODEL, D_IN), f32) * D_MODEL ** -0.5,
        "w_gk_up": nrm(ks[7], (DEPTH, GATE_RANK, GLA_QK), f32) * GATE_RANK ** -0.5,
        "b_gk": 0.1 * nrm(ks[8], (DEPTH, GLA_QK), f32),
        "gla_norm_w": 1.0 + 0.02 * nrm(ks[9], (DEPTH, GLA_DV), f32),
        "conv_w": nrm(ks[10], (DEPTH, CONV_W, CONV_DIM), f32) * CONV_W ** -0.5,
        "conv_b": 0.02 * nrm(ks[11], (DEPTH, CONV_DIM), f32),
        "dt_bias": dt + jnp.log(-jnp.expm1(-dt)),
        "a_log": jnp.log(jax.random.uniform(ks[13], (DEPTH, SSD_HEADS), f32, 1.0, 16.0)),
        "d_skip": 1.0 + 0.1 * nrm(ks[14], (DEPTH, SSD_HEADS), f32),
        "ssd_norm_w": 1.0 + 0.02 * nrm(ks[15], (DEPTH, SSD_WIDTH), f32),
        "w_out": nrm(ks[16], (DEPTH, D_MIX, D_MODEL), f32) * (D_MIX ** -0.5) * BETA,
        "ln1_g": 1.0 + 0.02 * nrm(ks[17], (DEPTH, D_MODEL), f32),
        "ln1_b": 0.02 * nrm(ks[18], (DEPTH, D_MODEL), f32),
        "w_up": nrm(ks[19], (DEPTH, D_MODEL, D_FF), f32) * D_MODEL ** -0.5,
        "w_down": nrm(ks[20], (DEPTH, D_FF, D_MODEL), f32) * (D_FF ** -0.5) * BETA,
        "ln2_g": 1.0 + 0.02 * nrm(ks[21], (DEPTH, D_MODEL), f32),
        "ln2_b": 0.02 * nrm(ks[22], (DEPTH, D_MODEL), f32),
    }


def reference(x_prompt, x_sample, state_gla, state_ssm, state_conv, meta_tokens, w_in, w_gk_up, b_gk,
              gla_norm_w, conv_w, conv_b, dt_bias, a_log, d_skip, ssd_norm_w, w_out, ln1_g, ln1_b,
              w_up, w_down, ln2_g, ln2_b):
    bp = x_prompt.shape[0]
    dt_ = x_prompt.dtype
    meta = jnp.broadcast_to(meta_tokens.astype(dt_)[None], (bp, N_META, D_MODEL))
    xp = jnp.concatenate([meta, x_prompt], axis=1)
    xs = x_sample
    gla_p, ssm_p, conv_p, gla_s, ssm_s, conv_s = [], [], [], [], [], []
    for l in range(DEPTH):
        p = (w_in[l], w_gk_up[l], b_gk[l], gla_norm_w[l], conv_w[l], conv_b[l], dt_bias[l], a_log[l],
             d_skip[l], ssd_norm_w[l], w_out[l], ln1_g[l], ln1_b[l], w_up[l], w_down[l], ln2_g[l], ln2_b[l])
        zg = jnp.zeros((bp, GLA_HEADS, GLA_DK, GLA_DV), dt_)
        zs = jnp.zeros((bp, SSD_HEADS, SSD_HEAD_DIM, D_STATE), dt_)
        zc = jnp.zeros((bp, CONV_W - 1, CONV_DIM), dt_)
        xp, g1, s1, c1 = _layer(xp, zg, zs, zc, N_META, *p)
        xs, g2, s2, c2 = _layer(xs, state_gla[l], state_ssm[l], state_conv[l], 0, *p)
        gla_p.append(g1); ssm_p.append(s1); conv_p.append(c1)
        gla_s.append(g2); ssm_s.append(s2); conv_s.append(c2)
    y_prompt = xp[:, N_META:]
    return (y_prompt, xs, jnp.stack(gla_p), jnp.stack(ssm_p), jnp.stack(conv_p),
            jnp.stack(gla_s), jnp.stack(ssm_s), jnp.stack(conv_s))
```

```cpp
#include <hip/hip_runtime.h>
#include <cstdio>
#include <cstdint>
namespace pg8 {
#define PG8_LAS __attribute__((address_space(3)))
typedef unsigned short bf16_t;
typedef short bf16x8 __attribute__((ext_vector_type(8)));
typedef float f32x4 __attribute__((ext_vector_type(4)));
typedef unsigned u32x4 __attribute__((ext_vector_type(4)));
constexpr int BM = 256, BK = 64, HALF = 128, HTB = HALF * BK * 2  , STAGE_BYTES = 8 * HTB, NXCD = 8, WGM = 8;

__host__ __device__ __forceinline__ int lds_byte(int r, int c) { const int st = (r >> 4) * 2 + (c >> 5), rr = r & 15, cc = c & 31, ob = rr * 64 + cc * 2; return st * 1024 + (ob ^ (((ob >> 9) & 1) << 5)); }
__host__ __device__ __forceinline__ void stage_rc(int b, int& R, int& C) { const int st = b / 1024, sb = b % 1024, swz = sb ^ (((sb >> 9) & 1) << 5); R = (st >> 1) * 16 + swz / 64; C = (st & 1) * 32 + (swz % 64) / 2; }
__host__ __device__ __forceinline__ int perm32(int rho) { const int n = rho >> 4, i = rho & 15; return 8 * (i >> 2) + 4 * n + (i & 3); }

struct Unit { int pm, pn; };
struct Gemm { const bf16_t* A; const bf16_t* Bt; int M, N, K; };

struct StaticOrder {
    int nM, nN, nwg, G, c;
    __host__ __device__ void init(int M, int N, int G_, int c_) { nM = M / BM; nN = N / BM; nwg = nM * nN; G = G_; c = c_; }
    __host__ __device__ bool next(int i, Unit& u) const {
        const long L = (long)i * G + c; if (L >= nwg) return false;
        int wgid = (int)L; { const int q = nwg / NXCD, r = nwg % NXCD, xcd = wgid % NXCD, off = wgid / NXCD; wgid = (xcd < r ? xcd * (q + 1) : r * (q + 1) + (xcd - r) * q) + off; }
        const int nig = WGM * nN, gid = wgid / nig, fm = gid * WGM, gsz = (nM - fm) < WGM ? (nM - fm) : WGM;
        u.pm = fm + ((wgid % nig) % gsz); u.pn = (wgid % nig) / gsz; return true;
    }
    __device__ __forceinline__ void a_ready(const Unit&) const {}
    __device__ __forceinline__ void done(const Unit&) const {}
};
__device__ __forceinline__ unsigned cvt_pk_bf16(float lo, float hi) { unsigned r; asm volatile("v_cvt_pk_bf16_f32 %0, %1, %2" : "=v"(r) : "v"(lo), "v"(hi)); return r; }
typedef unsigned u32x2 __attribute__((ext_vector_type(2)));

struct EpiInProj {
    static constexpr bool PERM = true, AFTER_DRAIN = false;
    bf16_t* U; float* UT; int ldu; int ntile_main;
    __device__ __forceinline__ void operator()(const f32x4 (&acc)[2][2][4][2], const Unit& u, int wr, int wc, int fr, int fq) const {
        const int row0 = u.pm * BM + wr * 64 + fr;
        if (u.pn < ntile_main) {
            const int col0 = u.pn * BM + wc * 32 + 8 * fq;
#pragma unroll
            for (int ai = 0; ai < 2; ++ai)
#pragma unroll
                for (int m = 0; m < 4; ++m) { bf16_t* rowp = U + (size_t)(row0 + ai * HALF + m * 16) * ldu + col0;
#pragma unroll
                    for (int bj = 0; bj < 2; ++bj) { const f32x4 v0 = acc[ai][bj][m][0], v1 = acc[ai][bj][m][1];
                        u32x4 w; w.x = cvt_pk_bf16(v0[0], v0[1]); w.y = cvt_pk_bf16(v0[2], v0[3]); w.z = cvt_pk_bf16(v1[0], v1[1]); w.w = cvt_pk_bf16(v1[2], v1[3]);
                        *(u32x4*)(rowp + bj * HALF) = w; } }
        } else if (wc < 2) {
            const int tc = wc * 32 + 8 * fq;
#pragma unroll
            for (int ai = 0; ai < 2; ++ai)
#pragma unroll
                for (int m = 0; m < 4; ++m) { float* rowp = UT + (size_t)(row0 + ai * HALF + m * 16) * 64 + tc;
                    *(f32x4*)(rowp) = acc[ai][0][m][0]; *(f32x4*)(rowp + 4) = acc[ai][0][m][1]; }
        }
    }
};
struct EpiRelu2 {
    static constexpr bool PERM = true, AFTER_DRAIN = false;
    bf16_t* O; int ldc;
    __device__ __forceinline__ void operator()(const f32x4 (&acc)[2][2][4][2], const Unit& u, int wr, int wc, int fr, int fq) const {
        const int row0 = u.pm * BM + wr * 64 + fr, col0 = u.pn * BM + wc * 32 + 8 * fq;
#pragma unroll
        for (int ai = 0; ai < 2; ++ai)
#pragma unroll
            for (int m = 0; m < 4; ++m) { bf16_t* rowp = O + (size_t)(row0 + ai * HALF + m * 16) * ldc + col0;
#pragma unroll
                for (int bj = 0; bj < 2; ++bj) { f32x4 v0 = acc[ai][bj][m][0], v1 = acc[ai][bj][m][1];
#pragma unroll
                    for (int j = 0; j < 4; ++j) { const float a = fmaxf(v0[j], 0.f), b = fmaxf(v1[j], 0.f); v0[j] = a * a; v1[j] = b * b; }
                    u32x4 w; w.x = cvt_pk_bf16(v0[0], v0[1]); w.y = cvt_pk_bf16(v0[2], v0[3]); w.z = cvt_pk_bf16(v1[0], v1[1]); w.w = cvt_pk_bf16(v1[2], v1[3]);
                    *(u32x4*)(rowp + bj * HALF) = w; } }
    }
};
struct RowMap {
    const float* xp; const float* xs; const float* meta; float* y; int tp, nmeta, seq, mprompt, mtot, d;
    __device__ __forceinline__ const float* src(int r) const {
        if (r < mprompt) { const int b = r / tp, t = r - b * tp; return t < nmeta ? meta + (size_t)t * d : xp + (size_t)(b * seq + t - nmeta) * d; }
        return xs + (size_t)(r - mprompt) * d;
    }
    __device__ __forceinline__ float* dst(int r) const {
        if (r < mprompt) { const int b = r / tp, t = r - b * tp; return t < nmeta ? nullptr : y + (size_t)(b * seq + t - nmeta) * d; }
        return r < mtot ? y + (size_t)(r - mprompt + (mprompt / tp) * seq) * d : nullptr;
    }
};
struct EpiResX {
    static constexpr bool PERM = false, AFTER_DRAIN = false;
    RowMap rm; float* out; int ldc; float alpha;
    __device__ __forceinline__ void operator()(const f32x4 (&acc)[2][2][4][2], const Unit& u, int wr, int wc, int fr, int fq) const {
        const int row0 = u.pm * BM + wr * 64 + fr, col0 = u.pn * BM + wc * 32 + 4 * fq;
#pragma unroll
        for (int ai = 0; ai < 2; ++ai)
#pragma unroll
            for (int m = 0; m < 4; ++m) { const int r = row0 + ai * HALF + m * 16;
                if (r < rm.mtot) { const float* s = rm.src(r) + col0; float* o = out + (size_t)r * ldc + col0;
#pragma unroll
                    for (int bj = 0; bj < 2; ++bj)
#pragma unroll
                        for (int n = 0; n < 2; ++n) { const f32x4 x = *(const f32x4*)(s + bj * HALF + n * 16); *(f32x4*)(o + bj * HALF + n * 16) = x * alpha + acc[ai][bj][m][n]; } } }
    }
};
struct EpiResH {
    static constexpr bool PERM = false, AFTER_DRAIN = false;
    RowMap rm; const bf16_t* hb; int ldc; float alpha;
    __device__ __forceinline__ void operator()(const f32x4 (&acc)[2][2][4][2], const Unit& u, int wr, int wc, int fr, int fq) const {
        const int row0 = u.pm * BM + wr * 64 + fr, col0 = u.pn * BM + wc * 32 + 4 * fq;
#pragma unroll
        for (int ai = 0; ai < 2; ++ai)
#pragma unroll
            for (int m = 0; m < 4; ++m) { const int r = row0 + ai * HALF + m * 16; float* o = rm.dst(r);
                if (o) { o += col0; const bf16_t* s = hb + (size_t)r * ldc + col0;
#pragma unroll
                    for (int bj = 0; bj < 2; ++bj)
#pragma unroll
                        for (int n = 0; n < 2; ++n) { const u32x2 hv = *(const u32x2*)(s + bj * HALF + n * 16);
                            f32x4 x; x[0] = __uint_as_float(hv.x << 16); x[1] = __uint_as_float(hv.x & 0xffff0000u); x[2] = __uint_as_float(hv.y << 16); x[3] = __uint_as_float(hv.y & 0xffff0000u);
                            *(f32x4*)(o + bj * HALF + n * 16) = x * alpha + acc[ai][bj][m][n]; } } }
    }
};

template <class Epi, class Sched, bool ALIGN_EPI = false, bool SP2 = false>
__device__ __forceinline__ void gemm_phase(PG8_LAS unsigned char* lds, const Gemm g, const Sched& S, const Epi& E) {
    const int tid = threadIdx.x, wid = __builtin_amdgcn_readfirstlane(tid >> 6), lane = tid & 63, wr = wid >> 2, wc = wid & 3, fr = lane & 15, fq = lane >> 4;
    const int K = g.K, nt = K / BK;
    unsigned voffA[2], voffB[2];
#pragma unroll
    for (int i = 0; i < 2; ++i) { int R, C; stage_rc(tid * 16 + i * 8192, R, C); const int Rb = Epi::PERM ? ((R & ~31) + perm32(R & 31)) : R;
        voffA[i] = (unsigned)(R * K + C) * 2u; voffB[i] = (unsigned)(Rb * K + C) * 2u; }
    const size_t kstep = (size_t)(BK * 2);
    const size_t hstep = (size_t)HALF * K * 2;
    const size_t tstep = 2 * hstep;
    const unsigned ldsw = (unsigned)wid * 1024u;
    const int aoff = lds_byte(wr * 64 + fr, fq * 8), boff = lds_byte(wc * 32 + fr, fq * 8);
#define PG8_SA(b, h) (((b) * 2 + (h)) * HTB)
#define PG8_SB(b, h) ((4 + (b) * 2 + (h)) * HTB)
#define PG8_STAGE(bufoff, gbase, voff) do { _Pragma("unroll") for (int _i = 0; _i < 2; ++_i) \
        __builtin_amdgcn_global_load_lds((const unsigned*)((const char*)(gbase) + (voff)[_i]), (PG8_LAS unsigned*)(lds + (bufoff) + ldsw + _i * 8192), 16, 0, 0); } while (0)
#define PG8_LDA(dst, b, h) do { _Pragma("unroll") for (int m = 0; m < 4; ++m) _Pragma("unroll") for (int k = 0; k < 2; ++k) dst[m][k] = *(const PG8_LAS bf16x8*)(lds + PG8_SA(b, h) + aoff + m * 2048 + k * 1024); } while (0)
#define PG8_LDB(dst, b, h) do { _Pragma("unroll") for (int n = 0; n < 2; ++n) _Pragma("unroll") for (int k = 0; k < 2; ++k) dst[n][k] = *(const PG8_LAS bf16x8*)(lds + PG8_SB(b, h) + boff + n * 2048 + k * 1024); } while (0)
#define PG8_MMA(ai, bj, At, Bt) do { __builtin_amdgcn_s_setprio(1); _Pragma("unroll") for (int m = 0; m < 4; ++m) _Pragma("unroll") for (int n = 0; n < 2; ++n) _Pragma("unroll") for (int k = 0; k < 2; ++k) \
        acc[ai][bj][m][n] = __builtin_amdgcn_mfma_f32_16x16x32_bf16(Bt[n][k], At[m][k], acc[ai][bj][m][n], 0, 0, 0); __builtin_amdgcn_s_setprio(0); } while (0)
#define PG8_WAIT_V(n) asm volatile("s_waitcnt vmcnt(" #n ")" ::: "memory")
#define PG8_WAIT_L(n) asm volatile("s_waitcnt lgkmcnt(" #n ")" ::: "memory")
#define PG8_BAR __builtin_amdgcn_s_barrier()
#define PG8_SCHED __builtin_amdgcn_sched_barrier(0)
    Unit cur, nxt; int ui = 0;
    if (!S.next(0, cur)) return;
    f32x4 acc[2][2][4][2];
#pragma unroll
    for (int a = 0; a < 2; ++a)
#pragma unroll
        for (int b = 0; b < 2; ++b)
#pragma unroll
            for (int m = 0; m < 4; ++m)
#pragma unroll
                for (int n = 0; n < 2; ++n) acc[a][b][m][n] = (f32x4){0.f, 0.f, 0.f, 0.f};
    bf16x8 At[4][2], B0[2][2], B1[2][2];
    const char* cA = (const char*)g.A + (size_t)cur.pm * tstep; const char* cB = (const char*)g.Bt + (size_t)cur.pn * tstep;
    S.a_ready(cur);
    if constexpr (SP2) {
        PG8_STAGE(PG8_SB(0, 0), cB, voffB); PG8_STAGE(PG8_SB(0, 1), cB + hstep, voffB); PG8_STAGE(PG8_SA(0, 0), cA, voffA); PG8_STAGE(PG8_SA(0, 1), cA + hstep, voffA);
        if (wr == 1) PG8_BAR;
        PG8_WAIT_V(2); PG8_BAR;
        PG8_STAGE(PG8_SB(1, 0), cB + kstep, voffB); PG8_STAGE(PG8_SA(1, 0), cA + kstep, voffA); PG8_STAGE(PG8_SB(1, 1), cB + hstep + kstep, voffB);
        PG8_WAIT_V(6); PG8_BAR;
    } else {
        PG8_STAGE(PG8_SB(0, 0), cB, voffB); PG8_STAGE(PG8_SA(0, 0), cA, voffA); PG8_STAGE(PG8_SB(0, 1), cB + hstep, voffB); PG8_STAGE(PG8_SA(0, 1), cA + hstep, voffA);
        if (wr == 1) PG8_BAR;
        PG8_WAIT_V(4); PG8_BAR;
        PG8_STAGE(PG8_SB(1, 0), cB + kstep, voffB); PG8_STAGE(PG8_SA(1, 0), cA + kstep, voffA); PG8_STAGE(PG8_SB(1, 1), cB + hstep + kstep, voffB);
        PG8_WAIT_V(6); PG8_BAR;
    }
    for (;;) {
        const bool has_next = S.next(ui + 1, nxt);
        const char* nA = has_next ? (const char*)g.A + (size_t)nxt.pm * tstep : cA; const char* nB = has_next ? (const char*)g.Bt + (size_t)nxt.pn * tstep : cB;
        for (int t = 0; t < nt; t += 2) {
            const bool last = (t == nt - 2);
            const char* a1 = cA + (size_t)(t + 1) * kstep;
            const char* a2 = last ? nA : cA + (size_t)(t + 2) * kstep; const char* b2 = last ? nB : cB + (size_t)(t + 2) * kstep;
            const char* a3 = a2 + kstep; const char* b3 = b2 + kstep;
            if (last && has_next) S.a_ready(nxt);
            if constexpr (SP2) {
            PG8_LDB(B0, 0, 0); PG8_LDB(B1, 0, 1); PG8_SCHED; PG8_LDA(At, 0, 0); PG8_STAGE(PG8_SA(1, 1), a1 + hstep, voffA);
            PG8_WAIT_V(8); PG8_WAIT_L(0); PG8_BAR; PG8_MMA(0, 0, At, B0); PG8_MMA(0, 1, At, B1); PG8_BAR; PG8_SCHED;
            PG8_LDA(At, 0, 1); PG8_STAGE(PG8_SB(0, 0), b2, voffB); PG8_STAGE(PG8_SB(0, 1), b2 + hstep, voffB); PG8_STAGE(PG8_SA(0, 0), a2, voffA);
            PG8_WAIT_V(8); PG8_WAIT_L(0); PG8_BAR; PG8_MMA(1, 0, At, B0); PG8_MMA(1, 1, At, B1); PG8_BAR; PG8_SCHED;
            PG8_LDB(B0, 1, 0); PG8_LDB(B1, 1, 1); PG8_SCHED; PG8_LDA(At, 1, 0); PG8_STAGE(PG8_SA(0, 1), a2 + hstep, voffA);
            PG8_WAIT_V(8); PG8_WAIT_L(0); PG8_BAR; PG8_MMA(0, 0, At, B0); PG8_MMA(0, 1, At, B1); PG8_BAR; PG8_SCHED;
            PG8_LDA(At, 1, 1); PG8_STAGE(PG8_SB(1, 0), b3, voffB); PG8_STAGE(PG8_SB(1, 1), b3 + hstep, voffB); PG8_STAGE(PG8_SA(1, 0), a3, voffA);
            PG8_WAIT_V(8); PG8_WAIT_L(0); PG8_BAR; PG8_MMA(1, 0, At, B0); PG8_MMA(1, 1, At, B1); PG8_BAR; PG8_SCHED;
            } else {
            PG8_LDB(B0, 0, 0); PG8_SCHED; PG8_LDA(At, 0, 0); PG8_STAGE(PG8_SA(1, 1), a1 + hstep, voffA);
            PG8_WAIT_L(8); PG8_BAR; PG8_WAIT_L(0); PG8_MMA(0, 0, At, B0); PG8_BAR; PG8_SCHED;
            PG8_LDB(B1, 0, 1); PG8_STAGE(PG8_SB(0, 0), b2, voffB);
            PG8_BAR; PG8_WAIT_L(0); PG8_MMA(0, 1, At, B1); PG8_BAR;
            PG8_LDA(At, 0, 1); PG8_STAGE(PG8_SA(0, 0), a2, voffA);
            PG8_BAR; PG8_WAIT_L(0); PG8_MMA(1, 0, At, B0); PG8_BAR; PG8_SCHED;
            PG8_STAGE(PG8_SB(0, 1), b2 + hstep, voffB);
            PG8_WAIT_V(6); PG8_BAR; PG8_MMA(1, 1, At, B1); PG8_BAR;
            PG8_LDB(B0, 1, 0); PG8_SCHED; PG8_LDA(At, 1, 0); PG8_STAGE(PG8_SA(0, 1), a2 + hstep, voffA);
            PG8_WAIT_L(8); PG8_BAR; PG8_WAIT_L(0); PG8_MMA(0, 0, At, B0); PG8_BAR; PG8_SCHED;
            PG8_LDB(B1, 1, 1); PG8_STAGE(PG8_SB(1, 0), b3, voffB);
            PG8_BAR; PG8_WAIT_L(0); PG8_MMA(0, 1, At, B1); PG8_BAR;
            PG8_LDA(At, 1, 1); PG8_STAGE(PG8_SA(1, 0), a3, voffA);
            PG8_BAR; PG8_WAIT_L(0); PG8_MMA(1, 0, At, B0); PG8_BAR; PG8_SCHED;
            PG8_STAGE(PG8_SB(1, 1), b3 + hstep, voffB);
            PG8_WAIT_V(6); PG8_BAR; PG8_MMA(1, 1, At, B1); PG8_BAR;
            }
        }
        if constexpr (ALIGN_EPI) { if (wr == 0) PG8_BAR; }
        if constexpr (!Epi::AFTER_DRAIN) { E(acc, cur, wr, wc, fr, fq); S.done(cur); }
        if (!has_next) break;
#pragma unroll
        for (int a = 0; a < 2; ++a)
#pragma unroll
            for (int b = 0; b < 2; ++b)
#pragma unroll
                for (int m = 0; m < 4; ++m)
#pragma unroll
                    for (int n = 0; n < 2; ++n) acc[a][b][m][n] = (f32x4){0.f, 0.f, 0.f, 0.f};
        cur = nxt; cA = nA; cB = nB; ++ui;
        if constexpr (ALIGN_EPI) { if (wr == 1) PG8_BAR; }
    }
    PG8_WAIT_V(0);
    if constexpr (!ALIGN_EPI) { if (wr == 0) PG8_BAR; }
    PG8_BAR;
    if constexpr (Epi::AFTER_DRAIN) { E.fused(acc, cur, wr, wc, fr, fq, lds, wid, lane); S.done(cur); }
#undef PG8_SA
#undef PG8_SB
#undef PG8_STAGE
#undef PG8_LDA
#undef PG8_LDB
#undef PG8_MMA
#undef PG8_WAIT_V
#undef PG8_WAIT_L
#undef PG8_BAR
#undef PG8_SCHED
}
}
#define GAS __attribute__((address_space(1)))
#define LAS __attribute__((address_space(3)))
typedef unsigned short bf16;
typedef unsigned v4u __attribute__((ext_vector_type(4)));
typedef float f32x4 __attribute__((ext_vector_type(4)));
typedef short bf16x8 __attribute__((ext_vector_type(8)));
typedef GAS unsigned gu32;
typedef GAS unsigned long long gu64;
#define RLX_AGENT __ATOMIC_RELAXED, __HIP_MEMORY_SCOPE_AGENT
#define LDS_WAIT() asm volatile("s_waitcnt lgkmcnt(0)" ::: "memory")
#define VM_WAIT() asm volatile("s_waitcnt vmcnt(0)" ::: "memory")
__device__ __forceinline__ unsigned long long rt() { return __builtin_amdgcn_s_memrealtime(); }
__device__ __forceinline__ unsigned f2bf(float f) { unsigned u = __builtin_bit_cast(unsigned, f); return (u + 0x7fffu + ((u >> 16) & 1u)) >> 16; }
__device__ __forceinline__ unsigned pk2(float lo, float hi) { return f2bf(lo) | (f2bf(hi) << 16); }

#define XB_TMO      128
#define XB_XCNT(j)  (256  + 64 * (j))
#define XB_XSUB(j)  (1280 + 64 * (j))
#define XB_XGEN(j)  (2304 + 64 * (j))
#define XB_TOP      3328
#define XB_TOPGEN   3392
#define XCD_BAR_WORDS 3456
#define XB_SPIN_CAP (1u << 22)

__device__ __forceinline__ unsigned xb_ld(unsigned* p)              { return __hip_atomic_load(p, __ATOMIC_RELAXED, __HIP_MEMORY_SCOPE_AGENT); }
__device__ __forceinline__ unsigned xb_add(unsigned* p, unsigned v) { return __hip_atomic_fetch_add(p, v, __ATOMIC_RELAXED, __HIP_MEMORY_SCOPE_AGENT); }
__device__ __forceinline__ unsigned xb_xcc_id() { return (unsigned)__builtin_amdgcn_s_getreg((3 << 11) | 20) & 0xFu; }
#define XB_SPIN(cond, bar) do { unsigned _sp = 0; while (cond) { __builtin_amdgcn_s_sleep(1); \
    if ((++_sp & 255u) == 0u) { if (xb_ld(&(bar)[XB_TMO])) break; if (_sp > XB_SPIN_CAP) { atomicAdd(&(bar)[XB_TMO], 1u); break; } } } } while (0)

struct XcdBarrier {
    unsigned* bar; unsigned x;
    volatile LAS unsigned* st;
};

__device__ __forceinline__ XcdBarrier xcd_barrier_post(unsigned* bar, volatile LAS unsigned* st) {
    XcdBarrier b; b.bar = bar; b.x = xb_xcc_id(); b.st = st;
    if (threadIdx.x == 0) (void)xb_add(&bar[XB_XCNT(b.x)], 1u);
    return b;
}
__device__ __forceinline__ void xcd_barrier_complete(unsigned* bar, unsigned x, unsigned& nloc, unsigned& nx) {
    const unsigned G = gridDim.x * gridDim.y * gridDim.z;
    unsigned sum, cnt, mine, sp = 0u;
    for (;;) {
        sum = 0u; cnt = 0u; mine = 0u;
#pragma unroll
        for (unsigned j = 0; j < 16; ++j) { const unsigned c = xb_ld(&bar[XB_XCNT(j)]); sum += c; cnt += (c > 0u) ? 1u : 0u; mine = (j == x) ? c : mine; }
        if (sum == G) break;
        __builtin_amdgcn_s_sleep(1);
        if ((++sp & 255u) == 0u) { if (xb_ld(&bar[XB_TMO])) break; if (sp > XB_SPIN_CAP) { atomicAdd(&bar[XB_TMO], 1u); break; } }
    }
    nloc = mine > 0u ? mine : 1u; nx = cnt > 0u ? cnt : 1u;
}

__device__ __forceinline__ void xcd_barrier(const XcdBarrier& b) {
    asm volatile("s_waitcnt vmcnt(0)" ::: "memory");
    __syncthreads();
    if (threadIdx.x == 0) {
        unsigned* bar = b.bar;
        __builtin_amdgcn_s_waitcnt(0);
        unsigned nloc = b.st[0], nx = b.st[1];
        if (nloc == 0u) { xcd_barrier_complete(bar, b.x, nloc, nx); b.st[0] = nloc; b.st[1] = nx; }
        const unsigned old = xb_add(&bar[XB_XSUB(b.x)], 1u);
        const unsigned gen = old / nloc;
        if (old + 1u == (gen + 1u) * nloc) {
            __builtin_amdgcn_fence(__ATOMIC_RELEASE, "agent");
            asm volatile("s_waitcnt vmcnt(0)" ::: "memory");
            const unsigned og = xb_add(&bar[XB_TOP], 1u);
            const unsigned tg = og / nx;
            if (og + 1u == (tg + 1u) * nx) xb_add(&bar[XB_TOPGEN], 1u);
            else XB_SPIN(xb_ld(&bar[XB_TOPGEN]) == tg, bar);
            __builtin_amdgcn_fence(__ATOMIC_ACQUIRE, "agent");
            xb_add(&bar[XB_XGEN(b.x)], 1u);
            asm volatile("s_waitcnt vmcnt(0)" ::: "memory");
        } else {
            XB_SPIN(xb_ld(&bar[XB_XGEN(b.x)]) == gen, bar);
            __builtin_amdgcn_fence(__ATOMIC_ACQUIRE, "agent");
            asm volatile("s_waitcnt vmcnt(0)" ::: "memory");
        }
    }
    __syncthreads();
}

constexpr int NWAVES = 8;
constexpr int D = 4096, BATCH = 4, SEQ = 2048, NMETA = 16, TP = SEQ + NMETA, MPROMPT = BATCH * TP;
constexpr int DEC_B = 128, DEC_T = 4, MSAMP = DEC_B * DEC_T, MTOT = MPROMPT + MSAMP, MP = 8960;
constexpr int GH = 4, DK = 256, DV = 512, QK = 1024, GW = 2048, RANK = 16;
constexpr int SW = 2048, HD = 64, SH = 32, SG = 8, NS = 128, CONV_DIM = 4096;
constexpr int DFF = 16384, DIN = 12336;
constexpr int NU = 12288, NIN_PAD = 12544;
constexpr int UC_Q = 0, UC_K = 1024, UC_V = 2048, UC_R = 4096, UC_Z = 6144, UC_XBC = 8192;
constexpr float ALPHA = 1.189207115002721f, EPS = 1e-5f;

constexpr size_t MiB = 1u << 20;
constexpr size_t WS_CTL = 0, CTL_ZERO_BYTES = 1 * MiB;
constexpr size_t WS_WIN = 1 * MiB, WS_WOUT = 99 * MiB, WS_WUP = 131 * MiB, WS_WDN = 259 * MiB;
constexpr size_t WS_XB = 387 * MiB;
constexpr size_t WS_U = 457 * MiB, WS_UT = 667 * MiB, WS_EG = 670 * MiB, WS_DTA = 705 * MiB, WS_XC = 708 * MiB, WS_OY = 845 * MiB;
constexpr size_t WS_MIX = 982 * MiB, WS_HB = 1052 * MiB, WS_END = 1122 * MiB;
constexpr size_t WS_PRE1 = WS_XC;
constexpr size_t WS_HID = WS_U;
static_assert(WS_WIN + (size_t)NIN_PAD * D * 2 <= WS_WOUT && WS_XB + (size_t)MP * D * 2 <= WS_U && WS_U + (size_t)MP * NU * 2 <= WS_UT && WS_UT + (size_t)MP * 64 * 4 <= WS_EG, "ws map 1");
static_assert(WS_EG + (size_t)MTOT * 1024 * 4 <= WS_DTA && WS_DTA + (size_t)MTOT * 64 * 4 <= WS_XC && WS_XC + (size_t)MTOT * D * 4 <= WS_OY && WS_OY + (size_t)MTOT * D * 4 <= WS_MIX, "ws map 2");
static_assert(WS_MIX + (size_t)MP * D * 2 <= WS_HB && WS_HB + (size_t)MP * D * 2 <= WS_END && WS_HID + (size_t)MP * DFF * 2 <= WS_OY, "ws map 3");
constexpr int CW_TMO = 0, CW_Q = 64, CW_BAR = 4096;

constexpr size_t O_YP = 0, O_YS = O_YP + (size_t)BATCH * SEQ * D, O_GP = O_YS + (size_t)MSAMP * D, O_SP = O_GP + (size_t)BATCH * GH * DK * DV,
                 O_CP = O_SP + (size_t)BATCH * SH * HD * NS, O_GS = O_CP + (size_t)BATCH * 3 * CONV_DIM, O_SS = O_GS + (size_t)DEC_B * GH * DK * DV,
                 O_CS = O_SS + (size_t)DEC_B * SH * HD * NS, O_END = O_CS + (size_t)DEC_B * 3 * CONV_DIM;

constexpr int RING_OFF = 0, RING_BYTES = 131072;
constexpr int LDSCTL_OFF = RING_BYTES, MISC_OFF = LDSCTL_OFF + 320;
constexpr int LDS_BYTES = 147456;

typedef float f32x2 __attribute__((ext_vector_type(2)));
__device__ __forceinline__ float bf_lo(unsigned w) { return __uint_as_float(w << 16); }
__device__ __forceinline__ float bf_hi(unsigned w) { return __uint_as_float(w & 0xffff0000u); }
__device__ __forceinline__ float wave_sum(float v) {
#pragma unroll
    for (int o = 1; o < 64; o <<= 1) v += __shfl_xor(v, o);
    return v;
}
__device__ __forceinline__ float silu_f(float x) { return x / (1.f + expf(-x)); }
__device__ __forceinline__ float softplus_f(float x) { return fmaxf(x, 0.f) + log1pf(expf(-fabsf(x))); }

struct Args { const float* in[23]; float* out; unsigned char* ws; int ph_lo, ph_hi; };

__device__ __forceinline__ void transpose_item(const float* W, int ldw, int K, int k0, int nsrc, bf16* WT, int ndst, int nvalid, LAS float* scr, int lane) {
#pragma unroll 8
    for (int i = 0; i < 32; ++i) { const int kk = 2 * i + (lane >> 5); scr[kk * 33 + (lane & 31)] = W[(size_t)(k0 + kk) * ldw + nsrc + (lane & 31)]; }
    LDS_WAIT(); asm volatile("" ::: "memory");
    const int c = lane & 7;
#pragma unroll
    for (int j = 0; j < 4; ++j) { const int n = (lane >> 3) + 8 * j; const LAS float* s = scr + (8 * c) * 33 + n;
        v4u o; o.x = pk2(s[0 * 33], s[1 * 33]); o.y = pk2(s[2 * 33], s[3 * 33]); o.z = pk2(s[4 * 33], s[5 * 33]); o.w = pk2(s[6 * 33], s[7 * 33]);
        if (n < nvalid) *(GAS v4u*)(WT + (size_t)(ndst + n) * K + k0 + 8 * c) = o; }
    LDS_WAIT(); asm volatile("" ::: "memory");
}
__device__ __forceinline__ void p0_prologue(const Args& A, LAS unsigned char* lds, int tid, int lane, int wave, int G) {
    unsigned char* ws = A.ws;
    bf16* WIN = (bf16*)(ws + WS_WIN); bf16* WOUT = (bf16*)(ws + WS_WOUT); bf16* WUP = (bf16*)(ws + WS_WUP); bf16* WDN = (bf16*)(ws + WS_WDN); bf16* XB = (bf16*)(ws + WS_XB);
    const float* w_in = A.in[6]; const float* w_out = A.in[16]; const float* w_up = A.in[19]; const float* w_down = A.in[20];
    LAS float* scr = (LAS float*)(lds + RING_OFF + wave * 16384);
    const int gw = blockIdx.x * NWAVES + wave, NGW = G * NWAVES;
    constexpr int NB_IN = 386, I_IN = (D / 64) * NB_IN, I_OUT = (D / 64) * (D / 32), I_UP = (D / 64) * (DFF / 32), I_DN = (DFF / 64) * (D / 32);
    constexpr int NITEMS = I_IN + I_OUT + I_UP + I_DN;
    for (int it = gw; it < NITEMS; it += NGW) {
        int r = it;
        if (r < I_IN) { const int kb = r / NB_IN, nb = r - kb * NB_IN; int nsrc, ndst, nv = 32;
            if (nb < 192) { nsrc = 32 * nb; ndst = nsrc; } else if (nb == 192) { nsrc = 6144; ndst = 12288; nv = 16; } else if (nb < 385) { nsrc = 6160 + 32 * (nb - 193); ndst = 6144 + 32 * (nb - 193); } else { nsrc = 12304; ndst = 12304; }
            transpose_item(w_in, DIN, D, 64 * kb, nsrc, WIN, ndst, nv, scr, lane); continue; }
        r -= I_IN;
        if (r < I_OUT) { const int kb = r / (D / 32), nb = r - kb * (D / 32); transpose_item(w_out, D, D, 64 * kb, 32 * nb, WOUT, 32 * nb, 32, scr, lane); continue; }
        r -= I_OUT;
        if (r < I_UP) { const int kb = r / (DFF / 32), nb = r - kb * (DFF / 32); transpose_item(w_up, DFF, D, 64 * kb, 32 * nb, WUP, 32 * nb, 32, scr, lane); continue; }
        r -= I_UP;
        { const int kb = r / (D / 32), nb = r - kb * (D / 32); transpose_item(w_down, D, DFF, 64 * kb, 32 * nb, WDN, 32 * nb, 32, scr, lane); }
    }
    { const size_t n16 = (size_t)(NIN_PAD - DIN) * D * 2 / 16; GAS v4u* z = (GAS v4u*)(WIN + (size_t)DIN * D);
      for (size_t i = (size_t)blockIdx.x * 512 + tid; i < n16; i += (size_t)G * 512) z[i] = (v4u){0u, 0u, 0u, 0u}; }
    pg8::RowMap rm{A.in[0], A.in[1], A.in[5], nullptr, TP, NMETA, SEQ, MPROMPT, MTOT, D};
    for (int r = gw; r < MP; r += NGW) {
        GAS unsigned long long* o8 = (GAS unsigned long long*)(XB + (size_t)r * D) + lane;
        if (r < MTOT) { const GAS f32x4* xr = (const GAS f32x4*)rm.src(r) + lane;
#pragma unroll 4
            for (int j = 0; j < 16; ++j) { const f32x4 v = xr[64 * j]; o8[64 * j] = (unsigned long long)pk2(v.x, v.y) | ((unsigned long long)pk2(v.z, v.w) << 32); } }
        else {
#pragma unroll 4
            for (int j = 0; j < 16; ++j) o8[64 * j] = 0ull; }
    }
}

__device__ __forceinline__ void p2_prepass(const Args& A, LAS unsigned char* lds, int tid, int G) {
    unsigned char* ws = A.ws;
    const bf16* U = (const bf16*)(ws + WS_U); const float* UT = (const float*)(ws + WS_UT); float* EG = (float*)(ws + WS_EG); float* DTA = (float*)(ws + WS_DTA); float* XC = (float*)(ws + WS_XC);
    const float* state_conv = A.in[4]; const float* w_gk_up = A.in[7]; const float* b_gk = A.in[8]; const float* conv_w = A.in[10]; const float* conv_b = A.in[11];
    const float* dt_bias = A.in[12]; const float* a_log = A.in[13];
    LAS float* uts = (LAS float*)(lds + RING_OFF);
    float wg0[RANK], wg1[RANK];
#pragma unroll
    for (int j = 0; j < RANK; ++j) { const f32x2 w = *(const f32x2*)(w_gk_up + j * QK + 2 * tid); wg0[j] = w.x; wg1[j] = w.y; }
    const f32x2 bg = *(const f32x2*)(b_gk + 2 * tid);
    float cw[4][8], cb[8];
#pragma unroll
    for (int j = 0; j < 4; ++j) { const f32x4 a = *(const f32x4*)(conv_w + j * CONV_DIM + 8 * tid), b = *(const f32x4*)(conv_w + j * CONV_DIM + 8 * tid + 4);
        cw[j][0] = a.x; cw[j][1] = a.y; cw[j][2] = a.z; cw[j][3] = a.w; cw[j][4] = b.x; cw[j][5] = b.y; cw[j][6] = b.z; cw[j][7] = b.w; }
    { const f32x4 a = *(const f32x4*)(conv_b + 8 * tid), b = *(const f32x4*)(conv_b + 8 * tid + 4); cb[0] = a.x; cb[1] = a.y; cb[2] = a.z; cb[3] = a.w; cb[4] = b.x; cb[5] = b.y; cb[6] = b.z; cb[7] = b.w; }
    const int hd = tid & 31; const float dtb = dt_bias[hd], aneg = -expf(a_log[hd]);
    constexpr int NRUN_P = BATCH * (TP / 16), NUNITS = NRUN_P + DEC_B;
    static_assert(TP % 16 == 0, "prompt runs");
    for (int u = blockIdx.x; u < NUNITS; u += G) {
        int r0, t0, L, rseq; const float* hist = nullptr;
        if (u < NRUN_P) { const int b = u / (TP / 16), c = u - b * (TP / 16); rseq = b * TP; t0 = 16 * c; r0 = rseq + t0; L = 16; }
        else { const int s = u - NRUN_P; rseq = MPROMPT + 4 * s; t0 = 0; r0 = rseq; L = 4; hist = state_conv + (size_t)s * 3 * CONV_DIM; }
        for (int i = tid; i < L * 64; i += 512) uts[i] = UT[(size_t)r0 * 64 + i];
        __syncthreads();
        for (int i = 0; i < L; ++i) { float z0 = bg.x, z1 = bg.y;
#pragma unroll
            for (int j = 0; j < RANK; ++j) { const float x = uts[i * 64 + j]; z0 += x * wg0[j]; z1 += x * wg1[j]; }
            f32x2 e; e.x = expf(-softplus_f(-z0) * (1.f / 16.f)); e.y = expf(-softplus_f(-z1) * (1.f / 16.f));
            *(f32x2*)(EG + (size_t)(r0 + i) * QK + 2 * tid) = e; }
        if (tid < 32 * L) { const int i = tid >> 5; const float dt = softplus_f(uts[i * 64 + 16 + hd] + dtb); DTA[(size_t)(r0 + i) * 64 + hd] = dt; DTA[(size_t)(r0 + i) * 64 + 32 + hd] = expf(dt * aneg); }
        { float xh[3][8];
#pragma unroll
          for (int j = 0; j < 3; ++j) { const int tau = t0 - 3 + j;
              if (tau >= 0) { const v4u w = *(const v4u*)(U + (size_t)(rseq + tau) * NU + UC_XBC + 8 * tid);
                  xh[j][0] = bf_lo(w.x); xh[j][1] = bf_hi(w.x); xh[j][2] = bf_lo(w.y); xh[j][3] = bf_hi(w.y); xh[j][4] = bf_lo(w.z); xh[j][5] = bf_hi(w.z); xh[j][6] = bf_lo(w.w); xh[j][7] = bf_hi(w.w); }
              else if (hist) { const f32x4 a = *(const f32x4*)(hist + (size_t)(3 + tau) * CONV_DIM + 8 * tid), b = *(const f32x4*)(hist + (size_t)(3 + tau) * CONV_DIM + 8 * tid + 4);
                  xh[j][0] = a.x; xh[j][1] = a.y; xh[j][2] = a.z; xh[j][3] = a.w; xh[j][4] = b.x; xh[j][5] = b.y; xh[j][6] = b.z; xh[j][7] = b.w; }
              else {
#pragma unroll
                  for (int e = 0; e < 8; ++e) xh[j][e] = 0.f; } }
          for (int i = 0; i < L; ++i) { const v4u w = *(const v4u*)(U + (size_t)(r0 + i) * NU + UC_XBC + 8 * tid); float x3[8];
              x3[0] = bf_lo(w.x); x3[1] = bf_hi(w.x); x3[2] = bf_lo(w.y); x3[3] = bf_hi(w.y); x3[4] = bf_lo(w.z); x3[5] = bf_hi(w.z); x3[6] = bf_lo(w.w); x3[7] = bf_hi(w.w);
              float o[8];
#pragma unroll
              for (int e = 0; e < 8; ++e) { const float v = cb[e] + cw[0][e] * xh[0][e] + cw[1][e] * xh[1][e] + cw[2][e] * xh[2][e] + cw[3][e] * x3[e]; o[e] = silu_f(v); xh[0][e] = xh[1][e]; xh[1][e] = xh[2][e]; xh[2][e] = x3[e]; }
              float* op = XC + (size_t)(r0 + i) * CONV_DIM + 8 * tid; *(f32x4*)op = (f32x4){o[0], o[1], o[2], o[3]}; *(f32x4*)(op + 4) = (f32x4){o[4], o[5], o[6], o[7]}; } }
        __syncthreads();
    }
    for (int u = blockIdx.x; u < (BATCH + DEC_B) * 3; u += G) { const int sq = u / 3, i = u - 3 * sq; int r; float* o;
        if (sq < BATCH) { r = sq * TP + TP - 3 + i; o = A.out + O_CP + (size_t)(sq * 3 + i) * CONV_DIM; } else { const int s = sq - BATCH; r = MPROMPT + 4 * s + 1 + i; o = A.out + O_CS + (size_t)(s * 3 + i) * CONV_DIM; }
        const v4u w = *(const v4u*)(U + (size_t)r * NU + UC_XBC + 8 * tid);
        *(f32x4*)(o + 8 * tid) = (f32x4){bf_lo(w.x), bf_hi(w.x), bf_lo(w.y), bf_hi(w.y)}; *(f32x4*)(o + 8 * tid + 4) = (f32x4){bf_lo(w.z), bf_hi(w.z), bf_lo(w.w), bf_hi(w.w)}; }
}

constexpr int TC = 16;
__device__ __forceinline__ void gla_prompt_unit(const Args& A, LAS unsigned char* lds, int tid, int lane, int w, int b, int h, int vs) {
    unsigned char* ws = A.ws;
    const bf16* U = (const bf16*)(ws + WS_U); const float* EG = (const float*)(ws + WS_EG); float* OY = (float*)(ws + WS_OY);
    LAS float* EGs = (LAS float*)(lds + RING_OFF); LAS float* Ks = EGs + TC * 256; LAS float* Qs = Ks + TC * 256; LAS float* Vs = Qs + TC * 256; LAS float* Os = Vs + TC * 32;
    f32x2 S[2][4];
#pragma unroll
    for (int i = 0; i < 2; ++i)
#pragma unroll
        for (int j = 0; j < 4; ++j) S[i][j] = (f32x2){0.f, 0.f};
    const bool hi32 = (lane & 32) != 0, hi16 = (lane & 16) != 0;
    for (int c0 = 0; c0 < TP; c0 += TC) {
        const int rbase = b * TP + c0;
#pragma unroll
        for (int i = 0; i < 2; ++i) { const int idx = tid + 512 * i, row = idx >> 6, c4 = idx & 63;
            *(LAS f32x4*)(EGs + row * 256 + 4 * c4) = *(const f32x4*)(EG + (size_t)(rbase + row) * QK + h * DK + 4 * c4); }
        { const int row = tid >> 5, c8 = tid & 31; const bf16* up = U + (size_t)(rbase + row) * NU + h * DK + 8 * c8;
          const v4u kw = *(const v4u*)(up + UC_K), qw = *(const v4u*)(up + UC_Q);
          *(LAS f32x4*)(Ks + row * 256 + 8 * c8) = (f32x4){bf_lo(kw.x), bf_hi(kw.x), bf_lo(kw.y), bf_hi(kw.y)}; *(LAS f32x4*)(Ks + row * 256 + 8 * c8 + 4) = (f32x4){bf_lo(kw.z), bf_hi(kw.z), bf_lo(kw.w), bf_hi(kw.w)};
          const float sc = 0.0625f;
          *(LAS f32x4*)(Qs + row * 256 + 8 * c8) = (f32x4){bf_lo(qw.x), bf_hi(qw.x), bf_lo(qw.y), bf_hi(qw.y)} * sc; *(LAS f32x4*)(Qs + row * 256 + 8 * c8 + 4) = (f32x4){bf_lo(qw.z), bf_hi(qw.z), bf_lo(qw.w), bf_hi(qw.w)} * sc; }
        if (tid < 64) { const int row = tid >> 2, c8 = tid & 3; const v4u vw = *(const v4u*)(U + (size_t)(rbase + row) * NU + UC_V + h * DV + vs * 32 + 8 * c8);
          *(LAS f32x4*)(Vs + row * 32 + 8 * c8) = (f32x4){bf_lo(vw.x), bf_hi(vw.x), bf_lo(vw.y), bf_hi(vw.y)}; *(LAS f32x4*)(Vs + row * 32 + 8 * c8 + 4) = (f32x4){bf_lo(vw.z), bf_hi(vw.z), bf_lo(vw.w), bf_hi(vw.w)}; }
        __syncthreads();
#pragma unroll 2
        for (int t = 0; t < TC; ++t) {
            const f32x4 eg = *(const LAS f32x4*)(EGs + t * 256 + 4 * lane), kk = *(const LAS f32x4*)(Ks + t * 256 + 4 * lane), qq = *(const LAS f32x4*)(Qs + t * 256 + 4 * lane), vv = *(const LAS f32x4*)(Vs + t * 32 + 4 * w);
            const f32x2 e2[2] = {(f32x2){eg.x, eg.y}, (f32x2){eg.z, eg.w}}, k2[2] = {(f32x2){kk.x, kk.y}, (f32x2){kk.z, kk.w}}, q2[2] = {(f32x2){qq.x, qq.y}, (f32x2){qq.z, qq.w}};
            float a[4];
#pragma unroll
            for (int j = 0; j < 4; ++j) { const float vj = vv[j]; f32x2 acc = (f32x2){0.f, 0.f};
#pragma unroll
                for (int i = 0; i < 2; ++i) { S[i][j] = S[i][j] * e2[i] + k2[i] * vj; acc = acc + q2[i] * S[i][j]; }
                a[j] = acc.x + acc.y; }
            const float s0 = hi32 ? a[0] : a[2], s1 = hi32 ? a[1] : a[3];
            float k0 = hi32 ? a[2] : a[0], k1 = hi32 ? a[3] : a[1];
            k0 += __shfl_xor(s0, 32); k1 += __shfl_xor(s1, 32);
            const float sn = hi16 ? k0 : k1; float kp = hi16 ? k1 : k0;
            kp += __shfl_xor(sn, 16); kp += __shfl_xor(kp, 8); kp += __shfl_xor(kp, 4); kp += __shfl_xor(kp, 2); kp += __shfl_xor(kp, 1);
            if ((lane & 15) == 0) Os[t * 32 + 4 * w + (lane >> 4)] = kp;
        }
        __syncthreads();
        { const int row = tid >> 5, c = tid & 31; OY[(size_t)(rbase + row) * D + h * DV + vs * 32 + c] = Os[row * 32 + c]; }
    }
    float* So = A.out + O_GP + ((size_t)(b * GH + h) * DK) * DV + vs * 32 + 4 * w;
#pragma unroll
    for (int i = 0; i < 2; ++i) { *(f32x4*)(So + (size_t)(4 * lane + 2 * i) * DV) = (f32x4){S[i][0].x, S[i][1].x, S[i][2].x, S[i][3].x}; *(f32x4*)(So + (size_t)(4 * lane + 2 * i + 1) * DV) = (f32x4){S[i][0].y, S[i][1].y, S[i][2].y, S[i][3].y}; }
    __syncthreads();
}
__device__ __forceinline__ void ssd_prompt_unit(const Args& A, LAS unsigned char* lds, int tid, int lane, int w, int b, int head) {
    unsigned char* ws = A.ws;
    const float* XC = (const float*)(ws + WS_XC); const float* DTA = (const float*)(ws + WS_DTA); float* OY = (float*)(ws + WS_OY);
    LAS float* Bs = (LAS float*)(lds + RING_OFF); LAS float* Cs = Bs + TC * 128; LAS float* DTXs = Cs + TC * 128; LAS float* Xs = DTXs + TC * 64; LAS float* DAs = Xs + TC * 64; LAS float* Ys = DAs + 64;
    const int g = head >> 2, ln = lane & 15, pr = lane >> 4, p0 = 8 * w + 2 * pr;
    const float dskip = A.in[14][head];
    f32x2 H[2][4];
#pragma unroll
    for (int i = 0; i < 2; ++i)
#pragma unroll
        for (int q = 0; q < 4; ++q) H[i][q] = (f32x2){0.f, 0.f};
    const bool hi8 = (lane & 8) != 0;
    for (int c0 = 0; c0 < TP; c0 += TC) {
        const int rbase = b * TP + c0;
        { const int row = tid >> 5, c4 = tid & 31; const float* xr = XC + (size_t)(rbase + row) * CONV_DIM;
          *(LAS f32x4*)(Bs + row * 128 + 4 * c4) = *(const f32x4*)(xr + SW + g * NS + 4 * c4); *(LAS f32x4*)(Cs + row * 128 + 4 * c4) = *(const f32x4*)(xr + SW + SG * NS + g * NS + 4 * c4); }
        if (tid < 256) { const int row = tid >> 4, c4 = tid & 15; const f32x4 x = *(const f32x4*)(XC + (size_t)(rbase + row) * CONV_DIM + head * HD + 4 * c4); const float dt = DTA[(size_t)(rbase + row) * 64 + head];
          *(LAS f32x4*)(Xs + row * 64 + 4 * c4) = x; *(LAS f32x4*)(DTXs + row * 64 + 4 * c4) = x * dt; }
        if (tid < TC) DAs[tid] = DTA[(size_t)(rbase + tid) * 64 + 32 + head];
        __syncthreads();
#pragma unroll 2
        for (int t = 0; t < TC; ++t) {
            const f32x4 b0 = *(const LAS f32x4*)(Bs + t * 128 + 4 * ln), b1 = *(const LAS f32x4*)(Bs + t * 128 + 64 + 4 * ln), c0v = *(const LAS f32x4*)(Cs + t * 128 + 4 * ln), c1v = *(const LAS f32x4*)(Cs + t * 128 + 64 + 4 * ln);
            const f32x2 dtx = *(const LAS f32x2*)(DTXs + t * 64 + p0); const float da = DAs[t];
            const f32x2 B2[4] = {(f32x2){b0.x, b0.y}, (f32x2){b0.z, b0.w}, (f32x2){b1.x, b1.y}, (f32x2){b1.z, b1.w}}, C2[4] = {(f32x2){c0v.x, c0v.y}, (f32x2){c0v.z, c0v.w}, (f32x2){c1v.x, c1v.y}, (f32x2){c1v.z, c1v.w}};
            float y[2];
#pragma unroll
            for (int i = 0; i < 2; ++i) { const float dx = dtx[i]; f32x2 acc = (f32x2){0.f, 0.f};
#pragma unroll
                for (int q = 0; q < 4; ++q) { H[i][q] = H[i][q] * da + B2[q] * dx; acc = acc + C2[q] * H[i][q]; }
                y[i] = acc.x + acc.y; }
            const float sn = hi8 ? y[0] : y[1]; float kp = hi8 ? y[1] : y[0];
            kp += __shfl_xor(sn, 8); kp += __shfl_xor(kp, 4); kp += __shfl_xor(kp, 2); kp += __shfl_xor(kp, 1);
            if ((lane & 7) == 0) Ys[t * 64 + p0 + ((lane >> 3) & 1)] = kp;
        }
        __syncthreads();
#pragma unroll
        for (int i = 0; i < 2; ++i) { const int idx = tid + 512 * i, row = idx >> 6, c = idx & 63; OY[(size_t)(rbase + row) * D + GW + head * HD + c] = Ys[idx] + dskip * Xs[idx]; }
    }
    float* Ho = A.out + O_SP + ((size_t)(b * SH + head) * HD) * NS;
#pragma unroll
    for (int i = 0; i < 2; ++i) { float* hp = Ho + (size_t)(p0 + i) * NS; *(f32x4*)(hp + 4 * ln) = (f32x4){H[i][0].x, H[i][0].y, H[i][1].x, H[i][1].y}; *(f32x4*)(hp + 64 + 4 * ln) = (f32x4){H[i][2].x, H[i][2].y, H[i][3].x, H[i][3].y}; }
    __syncthreads();
}
__device__ __forceinline__ void gla_sample_unit(const Args& A, LAS unsigned char* lds, int tid, int lane, int w, int s, int h) {
    unsigned char* ws = A.ws;
    const bf16* U = (const bf16*)(ws + WS_U); const float* EG = (const float*)(ws + WS_EG); float* OY = (float*)(ws + WS_OY);
    LAS f32x4* Gs = (LAS f32x4*)(lds + RING_OFF); LAS float* Vs = (LAS float*)(lds + RING_OFF + 16384); LAS float* Red = (LAS float*)(lds + RING_OFF + 24576);
    const int rb = MPROMPT + 4 * s;
#pragma unroll
    for (int i = 0; i < 2; ++i) { const int idx = tid + 512 * i, t = idx >> 8, k = idx & 255; const bf16* up = U + (size_t)(rb + t) * NU + h * DK + k;
        Gs[idx] = (f32x4){EG[(size_t)(rb + t) * QK + h * DK + k], __uint_as_float((unsigned)up[UC_K] << 16), __uint_as_float((unsigned)up[UC_Q] << 16) * 0.0625f, 0.f}; }
#pragma unroll
    for (int i = 0; i < 4; ++i) { const int idx = tid + 512 * i, t = idx >> 9, v = idx & 511; Vs[idx] = __uint_as_float((unsigned)U[(size_t)(rb + t) * NU + UC_V + h * DV + v] << 16); }
    __syncthreads();
    f32x4 vr[4][2], acc[4][2];
#pragma unroll
    for (int t = 0; t < 4; ++t) { vr[t][0] = *(const LAS f32x4*)(Vs + t * 512 + 8 * lane); vr[t][1] = *(const LAS f32x4*)(Vs + t * 512 + 8 * lane + 4); acc[t][0] = (f32x4){0.f, 0.f, 0.f, 0.f}; acc[t][1] = (f32x4){0.f, 0.f, 0.f, 0.f}; }
    const float* Sin = A.in[2] + ((size_t)(s * GH + h) * DK) * DV + 8 * lane; float* Sout = A.out + O_GS + ((size_t)(s * GH + h) * DK) * DV + 8 * lane;
    for (int kb = 0; kb < 32; kb += 4) {
        f32x4 s8[4][2];
#pragma unroll
        for (int u = 0; u < 4; ++u) { const float* p = Sin + (size_t)(32 * w + kb + u) * DV; s8[u][0] = *(const f32x4*)p; s8[u][1] = *(const f32x4*)(p + 4); }
#pragma unroll
        for (int u = 0; u < 4; ++u) { const int k = 32 * w + kb + u;
#pragma unroll
            for (int t = 0; t < 4; ++t) { const f32x4 g4 = Gs[t * 256 + k];
                s8[u][0] = s8[u][0] * g4.x + vr[t][0] * g4.y; s8[u][1] = s8[u][1] * g4.x + vr[t][1] * g4.y;
                acc[t][0] = acc[t][0] + s8[u][0] * g4.z; acc[t][1] = acc[t][1] + s8[u][1] * g4.z; }
            float* q = Sout + (size_t)k * DV; *(f32x4*)q = s8[u][0]; *(f32x4*)(q + 4) = s8[u][1]; }
    }
#pragma unroll
    for (int t = 0; t < 4; ++t) { *(LAS f32x4*)(Red + (w * 4 + t) * 512 + 8 * lane) = acc[t][0]; *(LAS f32x4*)(Red + (w * 4 + t) * 512 + 8 * lane + 4) = acc[t][1]; }
    __syncthreads();
#pragma unroll
    for (int i = 0; i < 4; ++i) { const int idx = tid + 512 * i, t = idx >> 9, v = idx & 511; float o = 0.f;
#pragma unroll
        for (int ww = 0; ww < 8; ++ww) o += Red[(ww * 4 + t) * 512 + v];
        OY[(size_t)(rb + t) * D + h * DV + v] = o; }
    __syncthreads();
}
__device__ __forceinline__ void ssd_sample_unit(const Args& A, LAS unsigned char* lds, int tid, int lane, int w, int s, int j) {
    unsigned char* ws = A.ws;
    const float* XC = (const float*)(ws + WS_XC); const float* DTA = (const float*)(ws + WS_DTA); float* OY = (float*)(ws + WS_OY);
    LAS float* Bs = (LAS float*)(lds + RING_OFF); LAS float* Cs = Bs + 1024; LAS float* Xs = Cs + 1024; LAS float* DTs = Xs + 2048; LAS float* DAs = DTs + 32; LAS float* Ys = DAs + 32;
    const int rb = MPROMPT + 4 * s;
    if (tid < 256) { const int t = tid >> 6, c4 = tid & 63; const float* xr = XC + (size_t)(rb + t) * CONV_DIM;
        *(LAS f32x4*)(Bs + t * 256 + 4 * c4) = *(const f32x4*)(xr + SW + j * 256 + 4 * c4); *(LAS f32x4*)(Cs + t * 256 + 4 * c4) = *(const f32x4*)(xr + SW + SG * NS + j * 256 + 4 * c4); }
    { const int t = tid >> 7, c4 = tid & 127; *(LAS f32x4*)(Xs + t * 512 + 4 * c4) = *(const f32x4*)(XC + (size_t)(rb + t) * CONV_DIM + j * 512 + 4 * c4); }
    if (tid < 32) { const int t = tid >> 3, hh = tid & 7; DTs[tid] = DTA[(size_t)(rb + t) * 64 + 8 * j + hh]; DAs[tid] = DTA[(size_t)(rb + t) * 64 + 32 + 8 * j + hh]; }
    __syncthreads();
    const int head = 8 * j + w, gl = w >> 2, pl = lane >> 5, nq = lane & 31;
    f32x4 B4[4], C4[4]; float dA[4], dt[4];
#pragma unroll
    for (int t = 0; t < 4; ++t) { B4[t] = *(const LAS f32x4*)(Bs + t * 256 + gl * 128 + 4 * nq); C4[t] = *(const LAS f32x4*)(Cs + t * 256 + gl * 128 + 4 * nq); dA[t] = DAs[t * 8 + w]; dt[t] = DTs[t * 8 + w]; }
    const float* Hin = A.in[3] + ((size_t)(s * SH + head) * HD) * NS + 4 * nq; float* Hout = A.out + O_SS + ((size_t)(s * SH + head) * HD) * NS + 4 * nq;
    const bool hi16 = (lane & 16) != 0, hi8 = (lane & 8) != 0;
    for (int pb = 0; pb < 32; pb += 4) {
        f32x4 h4[4];
#pragma unroll
        for (int u = 0; u < 4; ++u) h4[u] = *(const f32x4*)(Hin + (size_t)(2 * (pb + u) + pl) * NS);
#pragma unroll
        for (int u = 0; u < 4; ++u) { const int p = 2 * (pb + u) + pl; float y[4];
#pragma unroll
            for (int t = 0; t < 4; ++t) { const float dx = dt[t] * Xs[t * 512 + w * 64 + p]; h4[u] = h4[u] * dA[t] + B4[t] * dx; const f32x4 m = C4[t] * h4[u]; y[t] = (m.x + m.y) + (m.z + m.w); }
            *(f32x4*)(Hout + (size_t)p * NS) = h4[u];
            const float s0 = hi16 ? y[0] : y[2], s1 = hi16 ? y[1] : y[3];
            float k0 = hi16 ? y[2] : y[0], k1 = hi16 ? y[3] : y[1];
            k0 += __shfl_xor(s0, 16); k1 += __shfl_xor(s1, 16);
            const float sn = hi8 ? k0 : k1; float kp = hi8 ? k1 : k0;
            kp += __shfl_xor(sn, 8); kp += __shfl_xor(kp, 4); kp += __shfl_xor(kp, 2); kp += __shfl_xor(kp, 1);
            if ((lane & 7) == 0) Ys[(((lane >> 4) & 1) * 2 + ((lane >> 3) & 1)) * 512 + w * 64 + p] = kp; }
    }
    __syncthreads();
#pragma unroll
    for (int i = 0; i < 4; ++i) { const int idx = tid + 512 * i, t = idx >> 9, c = idx & 511; OY[(size_t)(rb + t) * D + GW + j * 512 + c] = Ys[idx] + A.in[14][8 * j + (c >> 6)] * Xs[idx]; }
    __syncthreads();
}

__device__ __forceinline__ void p4_finalize(const Args& A, int lane, int wave, int G) {
    unsigned char* ws = A.ws;
    const bf16* U = (const bf16*)(ws + WS_U); const float* OY = (const float*)(ws + WS_OY); bf16* MIX = (bf16*)(ws + WS_MIX);
    const float* gnw = A.in[9]; const float* snw = A.in[15];
    const int gw = blockIdx.x * NWAVES + wave, NGW = G * NWAVES;
    for (int r = gw; r < MP; r += NGW) {
        bf16* mr = MIX + (size_t)r * D;
        if (r >= MTOT) {
#pragma unroll 4
            for (int jj = 0; jj < 8; ++jj) *(GAS v4u*)(mr + 512 * jj + 8 * lane) = (v4u){0u, 0u, 0u, 0u};
            continue; }
        const float* orow = OY + (size_t)r * D; const bf16* ur = U + (size_t)r * NU;
#pragma unroll
        for (int h = 0; h < GH; ++h) {
            const f32x4 o0 = *(const f32x4*)(orow + h * DV + 8 * lane), o1 = *(const f32x4*)(orow + h * DV + 8 * lane + 4);
            float ss = (o0.x * o0.x + o0.y * o0.y) + (o0.z * o0.z + o0.w * o0.w) + (o1.x * o1.x + o1.y * o1.y) + (o1.z * o1.z + o1.w * o1.w);
            ss = wave_sum(ss); const float rinv = 1.f / sqrtf(ss * (1.f / DV) + EPS);
            const v4u rw = *(const v4u*)(ur + UC_R + h * DV + 8 * lane); const f32x4 w0 = *(const f32x4*)(gnw + 8 * lane), w1 = *(const f32x4*)(gnw + 8 * lane + 4);
            v4u m; m.x = pk2(o0.x * rinv * w0.x * silu_f(bf_lo(rw.x)), o0.y * rinv * w0.y * silu_f(bf_hi(rw.x))); m.y = pk2(o0.z * rinv * w0.z * silu_f(bf_lo(rw.y)), o0.w * rinv * w0.w * silu_f(bf_hi(rw.y)));
            m.z = pk2(o1.x * rinv * w1.x * silu_f(bf_lo(rw.z)), o1.y * rinv * w1.y * silu_f(bf_hi(rw.z))); m.w = pk2(o1.z * rinv * w1.z * silu_f(bf_lo(rw.w)), o1.w * rinv * w1.w * silu_f(bf_hi(rw.w)));
            *(GAS v4u*)(mr + h * DV + 8 * lane) = m;
        }
#pragma unroll
        for (int g = 0; g < SG; ++g) {
            const f32x4 y = *(const f32x4*)(orow + GW + g * 256 + 4 * lane); const pg8::u32x2 zw = *(const pg8::u32x2*)(ur + UC_Z + g * 256 + 4 * lane);
            const f32x4 yz = (f32x4){y.x * silu_f(bf_lo(zw.x)), y.y * silu_f(bf_hi(zw.x)), y.z * silu_f(bf_lo(zw.y)), y.w * silu_f(bf_hi(zw.y))};
            float ss = (yz.x * yz.x + yz.y * yz.y) + (yz.z * yz.z + yz.w * yz.w);
            ss = wave_sum(ss); const float rinv = 1.f / sqrtf(ss * (1.f / 256.f) + EPS);
            const f32x4 wn = *(const f32x4*)(snw + g * 256 + 4 * lane);
            pg8::u32x2 m; m.x = pk2(yz.x * rinv * wn.x, yz.y * rinv * wn.y); m.y = pk2(yz.z * rinv * wn.z, yz.w * rinv * wn.w);
            *(GAS pg8::u32x2*)(mr + GW + g * 256 + 4 * lane) = m;
        }
    }
}
template <bool OUT_BF16> __device__ __forceinline__ void ln_row(const float* xrow, const float* gam, const float* bet, void* orow, int lane) {
    const GAS f32x4* xr = (const GAS f32x4*)xrow + lane;
    f32x4 v[16]; float s = 0.f;
#pragma unroll
    for (int j = 0; j < 16; ++j) { v[j] = xr[64 * j]; s += (v[j].x + v[j].y) + (v[j].z + v[j].w); }
    const float mean = wave_sum(s) * (1.f / D); float s2 = 0.f;
#pragma unroll
    for (int j = 0; j < 16; ++j) { v[j] = v[j] - mean; s2 += (v[j].x * v[j].x + v[j].y * v[j].y) + (v[j].z * v[j].z + v[j].w * v[j].w); }
    const float rstd = 1.f / sqrtf(wave_sum(s2) * (1.f / D) + EPS);
#pragma unroll
    for (int j = 0; j < 16; ++j) { const f32x4 gm = *((const f32x4*)gam + lane + 64 * j), bt = *((const f32x4*)bet + lane + 64 * j); const f32x4 o = v[j] * rstd * gm + bt;
        if (OUT_BF16) ((GAS unsigned long long*)orow)[lane + 64 * j] = (unsigned long long)pk2(o.x, o.y) | ((unsigned long long)pk2(o.z, o.w) << 32);
        else ((GAS f32x4*)orow)[lane + 64 * j] = o; }
}

#ifndef MK_PER_PHASE
#define MK_PER_PHASE 0
#endif
constexpr int NPHASE = 10;
__global__ void __launch_bounds__(NWAVES * 64, 2) hymba_fwd(Args args) {
    extern __shared__ __attribute__((aligned(16))) unsigned char lds_raw[];
    LAS unsigned char* lds = (LAS unsigned char*)lds_raw;
    volatile LAS unsigned* MISC = (volatile LAS unsigned*)(lds + MISC_OFF);
    const int tid = threadIdx.x, lane = tid & 63, wave = __builtin_amdgcn_readfirstlane(tid >> 6), G = gridDim.x;
    unsigned char* ws = args.ws;
    gu32* ctl = (gu32*)(ws + WS_CTL);
    for (int u = tid; u < (LDS_BYTES - LDSCTL_OFF) / 4; u += NWAVES * 64) ((LAS unsigned*)(lds + LDSCTL_OFF))[u] = 0u;
    __syncthreads();
    XcdBarrier bar; bar.bar = (unsigned*)(ctl + CW_BAR); bar.x = 0; bar.st = nullptr;
    if (!MK_PER_PHASE) bar = xcd_barrier_post((unsigned*)(ctl + CW_BAR), MISC + 8);
    const int lo = args.ph_lo, hi = args.ph_hi;
#define IN(k) (lo <= (k) && (k) < hi)
#define SEAM(k) do { if (IN(k) && IN((k) + 1)) xcd_barrier(bar); } while (0)

    bf16* WIN = (bf16*)(ws + WS_WIN); bf16* WOUT = (bf16*)(ws + WS_WOUT); bf16* WUP = (bf16*)(ws + WS_WUP); bf16* WDN = (bf16*)(ws + WS_WDN);
    bf16* XB = (bf16*)(ws + WS_XB); bf16* Ub = (bf16*)(ws + WS_U); float* UT = (float*)(ws + WS_UT); bf16* MIX = (bf16*)(ws + WS_MIX); bf16* HB = (bf16*)(ws + WS_HB); bf16* HID = (bf16*)(ws + WS_HID);
    float* PRE1 = (float*)(ws + WS_PRE1);
    const pg8::RowMap rm{args.in[0], args.in[1], args.in[5], args.out + O_YP, TP, NMETA, SEQ, MPROMPT, MTOT, D};

    if (IN(0)) { p0_prologue(args, lds, tid, lane, wave, G); } SEAM(0);
    if (IN(1)) { pg8::Gemm g{XB, WIN, MP, NIN_PAD, D}; pg8::StaticOrder S; S.init(MP, NIN_PAD, G, (int)blockIdx.x);
        pg8::EpiInProj E{Ub, UT, NU, NU / 256};
        pg8::gemm_phase<pg8::EpiInProj, pg8::StaticOrder, true, true>(lds + RING_OFF, g, S, E); } SEAM(1);
    if (IN(2)) { p2_prepass(args, lds, tid, G); } SEAM(2);
    if (IN(3)) {
        for (int u = blockIdx.x; u < BATCH * GH * 16; u += G) gla_prompt_unit(args, lds, tid, lane, wave, u >> 6, (u >> 4) & 3, u & 15);
        for (int u = blockIdx.x; u < BATCH * SH; u += G) ssd_prompt_unit(args, lds, tid, lane, wave, u >> 5, u & 31);
        for (;;) {
            if (tid == 0) MISC[0] = __hip_atomic_fetch_add((unsigned*)(ctl + CW_Q), 1u, __ATOMIC_RELAXED, __HIP_MEMORY_SCOPE_AGENT);
            __syncthreads(); const int it = (int)MISC[0]; __syncthreads();
            if (it >= 2 * DEC_B * 4) break;
            if (it < DEC_B * 4) gla_sample_unit(args, lds, tid, lane, wave, it >> 2, it & 3);
            else ssd_sample_unit(args, lds, tid, lane, wave, (it - DEC_B * 4) >> 2, it & 3);
        }
    } SEAM(3);
    if (IN(4)) { p4_finalize(args, lane, wave, G); } SEAM(4);
    if (IN(5)) { pg8::Gemm g{MIX, WOUT, MP, D, D}; pg8::StaticOrder S; S.init(MP, D, G, (int)blockIdx.x);
        pg8::EpiResX E{rm, PRE1, D, ALPHA};
        pg8::gemm_phase<pg8::EpiResX, pg8::StaticOrder, true, true>(lds + RING_OFF, g, S, E); } SEAM(5);
    if (IN(6)) { const int gw = blockIdx.x * NWAVES + wave, NGW = G * NWAVES;
        for (int r = gw; r < MP; r += NGW) { bf16* o = HB + (size_t)r * D;
            if (r < MTOT) ln_row<true>(PRE1 + (size_t)r * D, args.in[17], args.in[18], o, lane);
            else {
#pragma unroll 4
                for (int j = 0; j < 16; ++j) ((GAS unsigned long long*)o)[lane + 64 * j] = 0ull; } } } SEAM(6);
    if (IN(7)) { pg8::Gemm g{HB, WUP, MP, DFF, D}; pg8::StaticOrder S; S.init(MP, DFF, G, (int)blockIdx.x);
        pg8::EpiRelu2 E{HID, DFF};
        pg8::gemm_phase<pg8::EpiRelu2, pg8::StaticOrder, true, true>(lds + RING_OFF, g, S, E); } SEAM(7);
    if (IN(8)) { pg8::Gemm g{HID, WDN, MP, D, DFF}; pg8::StaticOrder S; S.init(MP, D, G, (int)blockIdx.x);
        pg8::EpiResH E{rm, HB, D, ALPHA};
        pg8::gemm_phase<pg8::EpiResH, pg8::StaticOrder, true, true>(lds + RING_OFF, g, S, E); } SEAM(8);
    if (IN(9)) { const int gw = blockIdx.x * NWAVES + wave, NGW = G * NWAVES;
        for (int r = gw; r < BATCH * SEQ + MSAMP; r += NGW) { float* o = args.out + O_YP + (size_t)r * D; ln_row<false>(o, args.in[21], args.in[22], o, lane); } }
#undef IN
#undef SEAM
}

extern "C" void kernel_launch(void* const* d_in, const int* in_sizes, int n_in, void* d_out, int out_size, void* d_ws, size_t ws_size, hipStream_t stream) {
    static int grid = 0;
    if (grid == 0) {
        if (n_in != 23 || (size_t)out_size != O_END || ws_size < WS_END) { fprintf(stderr, "kernel_launch: shape mismatch: n_in %d out %d ws %zu (need 23, %zu, %zu)\n", n_in, out_size, ws_size, (size_t)O_END, (size_t)WS_END); grid = -1; return; }
        int dev = 0, cus = 0, per_cu = 0;
        if (hipGetDevice(&dev) != hipSuccess || hipDeviceGetAttribute(&cus, hipDeviceAttributeMultiprocessorCount, dev) != hipSuccess) { grid = -1; return; }
        if (hipFuncSetAttribute((const void*)hymba_fwd, hipFuncAttributeMaxDynamicSharedMemorySize, LDS_BYTES) != hipSuccess) { fprintf(stderr, "kernel_launch: hipFuncSetAttribute failed\n"); grid = -1; return; }
        if (hipOccupancyMaxActiveBlocksPerMultiprocessor(&per_cu, (const void*)hymba_fwd, NWAVES * 64, LDS_BYTES) != hipSuccess || per_cu < 1) { fprintf(stderr, "kernel_launch: occupancy query reports %d blocks per CU\n", per_cu); }
        (void)hipGetLastError();
        grid = cus;
    }
    if (grid < 0) return;
    (void)hipMemsetAsync((char*)d_ws + WS_CTL, 0, CTL_ZERO_BYTES, stream);
    Args a{};
    for (int i = 0; i < 23; ++i) a.in[i] = (const float*)d_in[i];
    a.out = (float*)d_out; a.ws = (unsigned char*)d_ws;
#if MK_PER_PHASE
    for (int p = 0; p < NPHASE; ++p) { a.ph_lo = p; a.ph_hi = p + 1; hipLaunchKernelGGL(hymba_fwd, dim3(grid), dim3(NWAVES * 64), LDS_BYTES, stream, a); }
#else
    a.ph_lo = 0; a.ph_hi = NPHASE;
    hipLaunchKernelGGL(hymba_fwd, dim3(grid), dim3(NWAVES * 64), LDS_BYTES, stream, a);
#endif
    const hipError_t le = hipPeekAtLastError();
    if (le != hipSuccess) fprintf(stderr, "kernel_launch: launch failed: %s\n", hipGetErrorName(le));
}
```

```cpp
#include <hip/hip_runtime.h>
#include <cstdio>
#include <cstdint>
namespace pg8 {
#define PG8_LAS __attribute__((address_space(3)))
typedef unsigned short bf16_t;
typedef short bf16x8 __attribute__((ext_vector_type(8)));
typedef float f32x4 __attribute__((ext_vector_type(4)));
typedef unsigned u32x4 __attribute__((ext_vector_type(4)));
constexpr int BM = 256, BK = 64, HALF = 128, HTB = HALF * BK * 2  , STAGE_BYTES = 8 * HTB, NXCD = 8, WGM = 8;

__host__ __device__ __forceinline__ int lds_byte(int r, int c) { const int st = (r >> 4) * 2 + (c >> 5), rr = r & 15, cc = c & 31, ob = rr * 64 + cc * 2; return st * 1024 + (ob ^ (((ob >> 9) & 1) << 5)); }
__host__ __device__ __forceinline__ void stage_rc(int b, int& R, int& C) { const int st = b / 1024, sb = b % 1024, swz = sb ^ (((sb >> 9) & 1) << 5); R = (st >> 1) * 16 + swz / 64; C = (st & 1) * 32 + (swz % 64) / 2; }
__host__ __device__ __forceinline__ int perm32(int rho) { const int n = rho >> 4, i = rho & 15; return 8 * (i >> 2) + 4 * n + (i & 3); }

struct Unit { int pm, pn, kt0, nkt; };
struct Gemm { const bf16_t* A; const bf16_t* Bt; int M, N, K; };

struct StaticOrder {
    static constexpr bool SPLITK = false;
    int nM, nN, nwg, G, c;
    __host__ __device__ void init(int M, int N, int G_, int c_) { nM = M / BM; nN = N / BM; nwg = nM * nN; G = G_; c = c_; }
    __host__ __device__ bool next(int i, Unit& u) const {
        const long L = (long)i * G + c; if (L >= nwg) return false;
        int wgid = (int)L; { const int q = nwg / NXCD, r = nwg % NXCD, xcd = wgid % NXCD, off = wgid / NXCD; wgid = (xcd < r ? xcd * (q + 1) : r * (q + 1) + (xcd - r) * q) + off; }
        const int nig = WGM * nN, gid = wgid / nig, fm = gid * WGM, gsz = (nM - fm) < WGM ? (nM - fm) : WGM;
        u.pm = fm + ((wgid % nig) % gsz); u.pn = (wgid % nig) / gsz; return true;
    }
    __device__ __forceinline__ void a_ready(const Unit&) const {}
    __device__ __forceinline__ void done(const Unit&) const {}
};

struct HybridOrder : StaticOrder {
    static constexpr bool SPLITK = true;
    int KT, nfull, rem, sp;
    __host__ __device__ void init(int M, int N, int K, int G_, int c_) { StaticOrder::init(M, N, G_, c_); KT = K / BK; nfull = nwg / G; rem = nwg - nfull * G; sp = rem ? G / rem : 1; if (sp > KT / 2) sp = KT / 2; }
    __host__ __device__ bool next(int i, Unit& u) const {
        if (i < nfull) { const bool ok = StaticOrder::next(i, u); u.kt0 = 0; u.nkt = KT; return ok; }
        if (i > nfull || c >= rem * sp) return false;
        const int cp = c % rem, s = c / rem; StaticOrder t = *this; t.c = cp; t.next(nfull, u);
        const int hp = KT / 2, p0 = (s * hp) / sp, p1 = ((s + 1) * hp) / sp; u.kt0 = 2 * p0; u.nkt = 2 * (p1 - p0); return true;
    }
    __host__ __device__ void tail_unit(int cp, Unit& u) const { StaticOrder t = *this; t.c = cp; t.next(nfull, u); }
    __host__ __device__ int slab_of(int s, int cp) const { return (s - 1) * rem + cp; }
    __device__ __forceinline__ void a_ready(const Unit&) const {}
    __device__ __forceinline__ void done(const Unit&) const {}
};
__device__ __forceinline__ unsigned cvt_pk_bf16(float lo, float hi) { unsigned r; asm volatile("v_cvt_pk_bf16_f32 %0, %1, %2" : "=v"(r) : "v"(lo), "v"(hi)); return r; }
typedef unsigned u32x2 __attribute__((ext_vector_type(2)));

struct EpiInProj {
    static constexpr bool PERM = true, AFTER_DRAIN = false;
    bf16_t* U; float* UT; int ldu; int ntile_main;
    __device__ __forceinline__ void operator()(const f32x4 (&acc)[2][2][4][2], const Unit& u, int wr, int wc, int fr, int fq) const {
        const int row0 = u.pm * BM + wr * 64 + fr;
        if (u.pn < ntile_main) {
            const int col0 = u.pn * BM + wc * 32 + 8 * fq;
#pragma unroll
            for (int ai = 0; ai < 2; ++ai)
#pragma unroll
                for (int m = 0; m < 4; ++m) { bf16_t* rowp = U + (size_t)(row0 + ai * HALF + m * 16) * ldu + col0;
#pragma unroll
                    for (int bj = 0; bj < 2; ++bj) { const f32x4 v0 = acc[ai][bj][m][0], v1 = acc[ai][bj][m][1];
                        u32x4 w; w.x = cvt_pk_bf16(v0[0], v0[1]); w.y = cvt_pk_bf16(v0[2], v0[3]); w.z = cvt_pk_bf16(v1[0], v1[1]); w.w = cvt_pk_bf16(v1[2], v1[3]);
                        *(u32x4*)(rowp + bj * HALF) = w; } }
        } else if (wc < 2) {
            const int tc = wc * 32 + 8 * fq;
#pragma unroll
            for (int ai = 0; ai < 2; ++ai)
#pragma unroll
                for (int m = 0; m < 4; ++m) { float* rowp = UT + (size_t)(row0 + ai * HALF + m * 16) * 64 + tc;
                    *(f32x4*)(rowp) = acc[ai][0][m][0]; *(f32x4*)(rowp + 4) = acc[ai][0][m][1]; }
        }
    }
};
struct EpiRelu2 {
    static constexpr bool PERM = true, AFTER_DRAIN = false;
    bf16_t* O; int ldc;
    __device__ __forceinline__ void operator()(const f32x4 (&acc)[2][2][4][2], const Unit& u, int wr, int wc, int fr, int fq) const {
        const int row0 = u.pm * BM + wr * 64 + fr, col0 = u.pn * BM + wc * 32 + 8 * fq;
#pragma unroll
        for (int ai = 0; ai < 2; ++ai)
#pragma unroll
            for (int m = 0; m < 4; ++m) { bf16_t* rowp = O + (size_t)(row0 + ai * HALF + m * 16) * ldc + col0;
#pragma unroll
                for (int bj = 0; bj < 2; ++bj) { f32x4 v0 = acc[ai][bj][m][0], v1 = acc[ai][bj][m][1];
#pragma unroll
                    for (int j = 0; j < 4; ++j) { const float a = fmaxf(v0[j], 0.f), b = fmaxf(v1[j], 0.f); v0[j] = a * a; v1[j] = b * b; }
                    u32x4 w; w.x = cvt_pk_bf16(v0[0], v0[1]); w.y = cvt_pk_bf16(v0[2], v0[3]); w.z = cvt_pk_bf16(v1[0], v1[1]); w.w = cvt_pk_bf16(v1[2], v1[3]);
                    *(u32x4*)(rowp + bj * HALF) = w; } }
    }
};
struct RowMap {
    const float* xp; const float* xs; const float* meta; float* y; int tp, nmeta, seq, mprompt, mtot, d;
    __device__ __forceinline__ const float* src(int r) const {
        if (r < mprompt) { const int b = r / tp, t = r - b * tp; return t < nmeta ? meta + (size_t)t * d : xp + (size_t)(b * seq + t - nmeta) * d; }
        return xs + (size_t)(r - mprompt) * d;
    }
    __device__ __forceinline__ const float* csrc(int rc) const { const int np = (mprompt / tp) * seq; return rc < np ? xp + (size_t)rc * d : xs + (size_t)(rc - np) * d; }
    __device__ __forceinline__ int xbrow(int rc) const { const int np = (mprompt / tp) * seq; return rc < np ? (rc / seq) * tp + nmeta + (rc % seq) : rc - np + mprompt; }
    __device__ __forceinline__ float* dst(int r) const {
        if (r < mprompt) { const int b = r / tp, t = r - b * tp; return t < nmeta ? nullptr : y + (size_t)(b * seq + t - nmeta) * d; }
        return r < mtot ? y + (size_t)(r - mprompt + (mprompt / tp) * seq) * d : nullptr;
    }
};
__device__ __forceinline__ void store_slab_perm(bf16_t* slab, const f32x4 (&acc)[2][2][4][2], int wr, int wc, int fr, int fq) {
#pragma unroll
    for (int ai = 0; ai < 2; ++ai)
#pragma unroll
        for (int m = 0; m < 4; ++m) { bf16_t* o = slab + (size_t)(ai * HALF + wr * 64 + m * 16 + fr) * BM + wc * 32 + 8 * fq;
#pragma unroll
            for (int bj = 0; bj < 2; ++bj) { const f32x4 v0 = acc[ai][bj][m][0], v1 = acc[ai][bj][m][1];
                u32x4 w; w.x = cvt_pk_bf16(v0[0], v0[1]); w.y = cvt_pk_bf16(v0[2], v0[3]); w.z = cvt_pk_bf16(v1[0], v1[1]); w.w = cvt_pk_bf16(v1[2], v1[3]);
                *(u32x4*)(o + bj * HALF) = w; } }
}
struct EpiResX {
    static constexpr bool PERM = true, AFTER_DRAIN = false;
    RowMap rm; const bf16_t* xb; bf16_t* out; int ldc; float alpha; bf16_t* slab;
    __device__ __forceinline__ void operator()(const f32x4 (&acc)[2][2][4][2], const Unit& u, int wr, int wc, int fr, int fq) const {
        if (u.kt0 != 0) { store_slab_perm(slab, acc, wr, wc, fr, fq); return; }
        const int row0 = u.pm * BM + wr * 64 + fr, col0 = u.pn * BM + wc * 32 + 8 * fq;
        u32x4 xr[2][4][2];
#pragma unroll
        for (int ai = 0; ai < 2; ++ai)
#pragma unroll
            for (int m = 0; m < 4; ++m) { const bf16_t* s = xb + (size_t)rm.xbrow(row0 + ai * HALF + m * 16) * ldc + col0;
#pragma unroll
                for (int bj = 0; bj < 2; ++bj) xr[ai][m][bj] = *(const u32x4*)(s + bj * HALF); }
#pragma unroll
        for (int ai = 0; ai < 2; ++ai)
#pragma unroll
            for (int m = 0; m < 4; ++m) { bf16_t* o = out + (size_t)(row0 + ai * HALF + m * 16) * ldc + col0;
#pragma unroll
                for (int bj = 0; bj < 2; ++bj) { const u32x4 hv = xr[ai][m][bj];
                    f32x4 x0, x1; x0[0] = __uint_as_float(hv.x << 16); x0[1] = __uint_as_float(hv.x & 0xffff0000u); x0[2] = __uint_as_float(hv.y << 16); x0[3] = __uint_as_float(hv.y & 0xffff0000u);
                    x1[0] = __uint_as_float(hv.z << 16); x1[1] = __uint_as_float(hv.z & 0xffff0000u); x1[2] = __uint_as_float(hv.w << 16); x1[3] = __uint_as_float(hv.w & 0xffff0000u);
                    const f32x4 v0 = x0 * alpha + acc[ai][bj][m][0], v1 = x1 * alpha + acc[ai][bj][m][1];
                    u32x4 w; w.x = cvt_pk_bf16(v0[0], v0[1]); w.y = cvt_pk_bf16(v0[2], v0[3]); w.z = cvt_pk_bf16(v1[0], v1[1]); w.w = cvt_pk_bf16(v1[2], v1[3]);
                    *(u32x4*)(o + bj * HALF) = w; } }
    }
};
struct EpiResH {
    static constexpr bool PERM = true, AFTER_DRAIN = false;
    bf16_t* out; const bf16_t* hb; int ldc; float alpha; bf16_t* slab;
    __device__ __forceinline__ void operator()(const f32x4 (&acc)[2][2][4][2], const Unit& u, int wr, int wc, int fr, int fq) const {
        if (u.kt0 != 0) { store_slab_perm(slab, acc, wr, wc, fr, fq); return; }
        const int row0 = u.pm * BM + wr * 64 + fr, col0 = u.pn * BM + wc * 32 + 8 * fq;
        u32x4 xr[2][4][2];
#pragma unroll
        for (int ai = 0; ai < 2; ++ai)
#pragma unroll
            for (int m = 0; m < 4; ++m) { const bf16_t* s = hb + (size_t)(row0 + ai * HALF + m * 16) * ldc + col0;
#pragma unroll
                for (int bj = 0; bj < 2; ++bj) xr[ai][m][bj] = *(const u32x4*)(s + bj * HALF); }
#pragma unroll
        for (int ai = 0; ai < 2; ++ai)
#pragma unroll
            for (int m = 0; m < 4; ++m) { bf16_t* o = out + (size_t)(row0 + ai * HALF + m * 16) * ldc + col0;
#pragma unroll
                for (int bj = 0; bj < 2; ++bj) { const u32x4 hv = xr[ai][m][bj];
                    f32x4 x0, x1; x0[0] = __uint_as_float(hv.x << 16); x0[1] = __uint_as_float(hv.x & 0xffff0000u); x0[2] = __uint_as_float(hv.y << 16); x0[3] = __uint_as_float(hv.y & 0xffff0000u);
                    x1[0] = __uint_as_float(hv.z << 16); x1[1] = __uint_as_float(hv.z & 0xffff0000u); x1[2] = __uint_as_float(hv.w << 16); x1[3] = __uint_as_float(hv.w & 0xffff0000u);
                    const f32x4 v0 = x0 * alpha + acc[ai][bj][m][0], v1 = x1 * alpha + acc[ai][bj][m][1];
                    u32x4 w; w.x = cvt_pk_bf16(v0[0], v0[1]); w.y = cvt_pk_bf16(v0[2], v0[3]); w.z = cvt_pk_bf16(v1[0], v1[1]); w.w = cvt_pk_bf16(v1[2], v1[3]);
                    *(u32x4*)(o + bj * HALF) = w; } }
    }
};

#ifndef KLOOP_OFF_V
#define KLOOP_OFF_V 44
#endif
constexpr int KLOOP_OFF = KLOOP_OFF_V;
template <class Epi, class Sched, bool ALIGN_EPI = false, bool SP2 = false>
__device__ __forceinline__ void gemm_phase(PG8_LAS unsigned char* lds, const Gemm g, const Sched& S, const Epi& E) {
    const int tid = threadIdx.x, wid = __builtin_amdgcn_readfirstlane(tid >> 6), lane = tid & 63, wr = wid >> 2, wc = wid & 3, fr = lane & 15, fq = lane >> 4;
    const int K = g.K, nt = K / BK;
    unsigned voffA[2], voffB[2];
#pragma unroll
    for (int i = 0; i < 2; ++i) { int R, C; stage_rc(tid * 16 + i * 8192, R, C); const int Rb = Epi::PERM ? ((R & ~31) + perm32(R & 31)) : R;
        voffA[i] = (unsigned)(R * K + C) * 2u; voffB[i] = (unsigned)(Rb * K + C) * 2u; }
    const size_t kstep = (size_t)(BK * 2);
    const size_t hstep = (size_t)HALF * K * 2;
    const size_t tstep = 2 * hstep;
    const unsigned ldsw = (unsigned)wid * 1024u;
    const int aoff = lds_byte(wr * 64 + fr, fq * 8), boff = lds_byte(wc * 32 + fr, fq * 8);
#define PG8_SA(b, h) (((b) * 2 + (h)) * HTB)
#define PG8_SB(b, h) ((4 + (b) * 2 + (h)) * HTB)
#define PG8_STAGE(bufoff, gbase, voff) do { _Pragma("unroll") for (int _i = 0; _i < 2; ++_i) \
        __builtin_amdgcn_global_load_lds((const unsigned*)((const char*)(gbase) + (voff)[_i]), (PG8_LAS unsigned*)(lds + (bufoff) + ldsw + _i * 8192), 16, 0, 0); } while (0)
#define PG8_LDA(dst, b, h) do { _Pragma("unroll") for (int m = 0; m < 4; ++m) _Pragma("unroll") for (int k = 0; k < 2; ++k) dst[m][k] = *(const PG8_LAS bf16x8*)(lds + PG8_SA(b, h) + aoff + m * 2048 + k * 1024); } while (0)
#define PG8_LDB(dst, b, h) do { _Pragma("unroll") for (int n = 0; n < 2; ++n) _Pragma("unroll") for (int k = 0; k < 2; ++k) dst[n][k] = *(const PG8_LAS bf16x8*)(lds + PG8_SB(b, h) + boff + n * 2048 + k * 1024); } while (0)
#define PG8_MMA(ai, bj, At, Bt) do { __builtin_amdgcn_s_setprio(1); _Pragma("unroll") for (int m = 0; m < 4; ++m) _Pragma("unroll") for (int n = 0; n < 2; ++n) _Pragma("unroll") for (int k = 0; k < 2; ++k) \
        acc[ai][bj][m][n] = __builtin_amdgcn_mfma_f32_16x16x32_bf16(Bt[n][k], At[m][k], acc[ai][bj][m][n], 0, 0, 0); __builtin_amdgcn_s_setprio(0); } while (0)
#define PG8_WAIT_V(n) asm volatile("s_waitcnt vmcnt(" #n ")" ::: "memory")
#define PG8_WAIT_L(n) asm volatile("s_waitcnt lgkmcnt(" #n ")" ::: "memory")
#define PG8_BAR __builtin_amdgcn_s_barrier()
#define PG8_SCHED __builtin_amdgcn_sched_barrier(0)
    Unit cur, nxt; int ui = 0;
    if (!S.next(0, cur)) return;
    if constexpr (!Sched::SPLITK) { cur.kt0 = 0; cur.nkt = nt; }
    f32x4 acc[2][2][4][2];
#pragma unroll
    for (int a = 0; a < 2; ++a)
#pragma unroll
        for (int b = 0; b < 2; ++b)
#pragma unroll
            for (int m = 0; m < 4; ++m)
#pragma unroll
                for (int n = 0; n < 2; ++n) acc[a][b][m][n] = (f32x4){0.f, 0.f, 0.f, 0.f};
    bf16x8 At[4][2], B0[2][2], B1[2][2];
    const char* cA = (const char*)g.A + (size_t)cur.pm * tstep + (size_t)cur.kt0 * kstep; const char* cB = (const char*)g.Bt + (size_t)cur.pn * tstep + (size_t)cur.kt0 * kstep;
    S.a_ready(cur);
    if constexpr (SP2) {
        PG8_STAGE(PG8_SB(0, 0), cB, voffB); PG8_STAGE(PG8_SB(0, 1), cB + hstep, voffB); PG8_STAGE(PG8_SA(0, 0), cA, voffA); PG8_STAGE(PG8_SA(0, 1), cA + hstep, voffA);
        if (wr == 1) PG8_BAR;
        PG8_WAIT_V(2); PG8_BAR;
        PG8_STAGE(PG8_SB(1, 0), cB + kstep, voffB); PG8_STAGE(PG8_SA(1, 0), cA + kstep, voffA); PG8_STAGE(PG8_SB(1, 1), cB + hstep + kstep, voffB);
        PG8_WAIT_V(6); PG8_BAR;
    } else {
        PG8_STAGE(PG8_SB(0, 0), cB, voffB); PG8_STAGE(PG8_SA(0, 0), cA, voffA); PG8_STAGE(PG8_SB(0, 1), cB + hstep, voffB); PG8_STAGE(PG8_SA(0, 1), cA + hstep, voffA);
        if (wr == 1) PG8_BAR;
        PG8_WAIT_V(4); PG8_BAR;
        PG8_STAGE(PG8_SB(1, 0), cB + kstep, voffB); PG8_STAGE(PG8_SA(1, 0), cA + kstep, voffA); PG8_STAGE(PG8_SB(1, 1), cB + hstep + kstep, voffB);
        PG8_WAIT_V(6); PG8_BAR;
    }
    for (;;) {
        const bool has_next = S.next(ui + 1, nxt);
        if constexpr (!Sched::SPLITK) { nxt.kt0 = 0; nxt.nkt = nt; }
        const int cnt = cur.nkt;
        const char* nA = has_next ? (const char*)g.A + (size_t)nxt.pm * tstep + (size_t)nxt.kt0 * kstep : cA; const char* nB = has_next ? (const char*)g.Bt + (size_t)nxt.pn * tstep + (size_t)nxt.kt0 * kstep : cB;
        { constexpr int pre = Sched::SPLITK ? 0 : 20, nops = ((KLOOP_OFF - pre + 64) % 64) / 4;
          asm volatile(".p2align 6\n\t.rept %0\n\ts_nop 0\n\t.endr" :: "i"(nops) : "memory"); }
        for (int t = 0; t < cnt; t += 2) {
            const bool last = (t == cnt - 2);
            const char* a1 = cA + (size_t)(t + 1) * kstep;
            const char* a2 = last ? nA : cA + (size_t)(t + 2) * kstep; const char* b2 = last ? nB : cB + (size_t)(t + 2) * kstep;
            const char* a3 = a2 + kstep; const char* b3 = b2 + kstep;
            if (last && has_next) S.a_ready(nxt);
            if constexpr (SP2) {
            PG8_LDB(B0, 0, 0); PG8_LDB(B1, 0, 1); PG8_SCHED; PG8_LDA(At, 0, 0); PG8_STAGE(PG8_SA(1, 1), a1 + hstep, voffA);
            PG8_WAIT_V(8); PG8_WAIT_L(0); PG8_BAR; PG8_MMA(0, 0, At, B0); PG8_MMA(0, 1, At, B1); PG8_BAR; PG8_SCHED;
            PG8_LDA(At, 0, 1); PG8_STAGE(PG8_SB(0, 0), b2, voffB); PG8_STAGE(PG8_SB(0, 1), b2 + hstep, voffB); PG8_STAGE(PG8_SA(0, 0), a2, voffA);
            PG8_WAIT_V(8); PG8_WAIT_L(0); PG8_BAR; PG8_MMA(1, 0, At, B0); PG8_MMA(1, 1, At, B1); PG8_BAR; PG8_SCHED;
            PG8_LDB(B0, 1, 0); PG8_LDB(B1, 1, 1); PG8_SCHED; PG8_LDA(At, 1, 0); PG8_STAGE(PG8_SA(0, 1), a2 + hstep, voffA);
            PG8_WAIT_V(8); PG8_WAIT_L(0); PG8_BAR; PG8_MMA(0, 0, At, B0); PG8_MMA(0, 1, At, B1); PG8_BAR; PG8_SCHED;
            PG8_LDA(At, 1, 1); PG8_STAGE(PG8_SB(1, 0), b3, voffB); PG8_STAGE(PG8_SB(1, 1), b3 + hstep, voffB); PG8_STAGE(PG8_SA(1, 0), a3, voffA);
            PG8_WAIT_V(8); PG8_WAIT_L(0); PG8_BAR; PG8_MMA(1, 0, At, B0); PG8_MMA(1, 1, At, B1); PG8_BAR; PG8_SCHED;
            } else {
            PG8_LDB(B0, 0, 0); PG8_SCHED; PG8_LDA(At, 0, 0); PG8_STAGE(PG8_SA(1, 1), a1 + hstep, voffA);
            PG8_WAIT_L(8); PG8_BAR; PG8_WAIT_L(0); PG8_MMA(0, 0, At, B0); PG8_BAR; PG8_SCHED;
            PG8_LDB(B1, 0, 1); PG8_STAGE(PG8_SB(0, 0), b2, voffB);
            PG8_BAR; PG8_WAIT_L(0); PG8_MMA(0, 1, At, B1); PG8_BAR;
            PG8_LDA(At, 0, 1); PG8_STAGE(PG8_SA(0, 0), a2, voffA);
            PG8_BAR; PG8_WAIT_L(0); PG8_MMA(1, 0, At, B0); PG8_BAR; PG8_SCHED;
            PG8_STAGE(PG8_SB(0, 1), b2 + hstep, voffB);
            PG8_WAIT_V(6); PG8_BAR; PG8_MMA(1, 1, At, B1); PG8_BAR;
            PG8_LDB(B0, 1, 0); PG8_SCHED; PG8_LDA(At, 1, 0); PG8_STAGE(PG8_SA(0, 1), a2 + hstep, voffA);
            PG8_WAIT_L(8); PG8_BAR; PG8_WAIT_L(0); PG8_MMA(0, 0, At, B0); PG8_BAR; PG8_SCHED;
            PG8_LDB(B1, 1, 1); PG8_STAGE(PG8_SB(1, 0), b3, voffB);
            PG8_BAR; PG8_WAIT_L(0); PG8_MMA(0, 1, At, B1); PG8_BAR;
            PG8_LDA(At, 1, 1); PG8_STAGE(PG8_SA(1, 0), a3, voffA);
            PG8_BAR; PG8_WAIT_L(0); PG8_MMA(1, 0, At, B0); PG8_BAR; PG8_SCHED;
            PG8_STAGE(PG8_SB(1, 1), b3 + hstep, voffB);
            PG8_WAIT_V(6); PG8_BAR; PG8_MMA(1, 1, At, B1); PG8_BAR;
            }
        }
        if constexpr (ALIGN_EPI) { if (wr == 0) PG8_BAR; }
        if constexpr (!Epi::AFTER_DRAIN) { E(acc, cur, wr, wc, fr, fq); S.done(cur); }
        if (!has_next) break;
#pragma unroll
        for (int a = 0; a < 2; ++a)
#pragma unroll
            for (int b = 0; b < 2; ++b)
#pragma unroll
                for (int m = 0; m < 4; ++m)
#pragma unroll
                    for (int n = 0; n < 2; ++n) acc[a][b][m][n] = (f32x4){0.f, 0.f, 0.f, 0.f};
        cur = nxt; cA = nA; cB = nB; ++ui;
        if constexpr (ALIGN_EPI) { if (wr == 1) PG8_BAR; }
    }
    PG8_WAIT_V(0);
    if constexpr (!ALIGN_EPI) { if (wr == 0) PG8_BAR; }
    PG8_BAR;
    if constexpr (Epi::AFTER_DRAIN) { E.fused(acc, cur, wr, wc, fr, fq, lds, wid, lane); S.done(cur); }
#undef PG8_SA
#undef PG8_SB
#undef PG8_STAGE
#undef PG8_LDA
#undef PG8_LDB
#undef PG8_MMA
#undef PG8_WAIT_V
#undef PG8_WAIT_L
#undef PG8_BAR
#undef PG8_SCHED
}
}
#define GAS __attribute__((address_space(1)))
#define LAS __attribute__((address_space(3)))
typedef unsigned short bf16;
typedef unsigned v4u __attribute__((ext_vector_type(4)));
typedef float f32x4 __attribute__((ext_vector_type(4)));
typedef short bf16x8 __attribute__((ext_vector_type(8)));
typedef GAS unsigned gu32;
typedef GAS unsigned long long gu64;
#define RLX_AGENT __ATOMIC_RELAXED, __HIP_MEMORY_SCOPE_AGENT
#define LDS_WAIT() asm volatile("s_waitcnt lgkmcnt(0)" ::: "memory")
#define VM_WAIT() asm volatile("s_waitcnt vmcnt(0)" ::: "memory")
__device__ __forceinline__ unsigned long long rt() { return __builtin_amdgcn_s_memrealtime(); }
__device__ __forceinline__ unsigned f2bf(float f) { unsigned u = __builtin_bit_cast(unsigned, f); return (u + 0x7fffu + ((u >> 16) & 1u)) >> 16; }
__device__ __forceinline__ unsigned pk2_sw(float lo, float hi) { return f2bf(lo) | (f2bf(hi) << 16); }
__device__ __forceinline__ unsigned pk2(float lo, float hi) { unsigned r; asm("v_cvt_pk_bf16_f32 %0, %1, %2" : "=v"(r) : "v"(lo), "v"(hi)); return r; }

#define XB_TMO      128
#define XB_XCNT(j)  (256  + 64 * (j))
#define XB_XSUB(j)  (1280 + 64 * (j))
#define XB_XGEN(j)  (2304 + 64 * (j))
#define XB_TOP      3328
#define XB_TOPGEN   3392
#define XCD_BAR_WORDS 3456
#define XB_SPIN_CAP (1u << 22)

__device__ __forceinline__ unsigned xb_ld(unsigned* p)              { return __hip_atomic_load(p, __ATOMIC_RELAXED, __HIP_MEMORY_SCOPE_AGENT); }
__device__ __forceinline__ unsigned xb_add(unsigned* p, unsigned v) { return __hip_atomic_fetch_add(p, v, __ATOMIC_RELAXED, __HIP_MEMORY_SCOPE_AGENT); }
__device__ __forceinline__ unsigned xb_xcc_id() { return (unsigned)__builtin_amdgcn_s_getreg((3 << 11) | 20) & 0xFu; }
#define XB_SPIN(cond, bar) do { unsigned _sp = 0; while (cond) { __builtin_amdgcn_s_sleep(1); \
    if ((++_sp & 255u) == 0u) { if (xb_ld(&(bar)[XB_TMO])) break; if (_sp > XB_SPIN_CAP) { atomicAdd(&(bar)[XB_TMO], 1u); break; } } } } while (0)

struct XcdBarrier {
    unsigned* bar; unsigned x;
    volatile LAS unsigned* st;
};

__device__ __forceinline__ XcdBarrier xcd_barrier_post(unsigned* bar, volatile LAS unsigned* st) {
    XcdBarrier b; b.bar = bar; b.x = xb_xcc_id(); b.st = st;
    if (threadIdx.x == 0) (void)xb_add(&bar[XB_XCNT(b.x)], 1u);
    return b;
}
__device__ __forceinline__ void xcd_barrier_complete(unsigned* bar, unsigned x, unsigned& nloc, unsigned& nx) {
    const unsigned G = gridDim.x * gridDim.y * gridDim.z;
    unsigned sum, cnt, mine, sp = 0u;
    for (;;) {
        sum = 0u; cnt = 0u; mine = 0u;
#pragma unroll
        for (unsigned j = 0; j < 16; ++j) { const unsigned c = xb_ld(&bar[XB_XCNT(j)]); sum += c; cnt += (c > 0u) ? 1u : 0u; mine = (j == x) ? c : mine; }
        if (sum == G) break;
        __builtin_amdgcn_s_sleep(1);
        if ((++sp & 255u) == 0u) { if (xb_ld(&bar[XB_TMO])) break; if (sp > XB_SPIN_CAP) { atomicAdd(&bar[XB_TMO], 1u); break; } }
    }
    nloc = mine > 0u ? mine : 1u; nx = cnt > 0u ? cnt : 1u;
}

__device__ __forceinline__ void xcd_barrier(const XcdBarrier& b) {
    asm volatile("s_waitcnt vmcnt(0)" ::: "memory");
    __syncthreads();
    if (threadIdx.x == 0) {
        unsigned* bar = b.bar;
        __builtin_amdgcn_s_waitcnt(0);
        unsigned nloc = b.st[0], nx = b.st[1];
        if (nloc == 0u) { xcd_barrier_complete(bar, b.x, nloc, nx); b.st[0] = nloc; b.st[1] = nx; }
        const unsigned old = xb_add(&bar[XB_XSUB(b.x)], 1u);
        const unsigned gen = old / nloc;
        if (old + 1u == (gen + 1u) * nloc) {
            __builtin_amdgcn_fence(__ATOMIC_RELEASE, "agent");
            asm volatile("s_waitcnt vmcnt(0)" ::: "memory");
            const unsigned og = xb_add(&bar[XB_TOP], 1u);
            const unsigned tg = og / nx;
            if (og + 1u == (tg + 1u) * nx) xb_add(&bar[XB_TOPGEN], 1u);
            else XB_SPIN(xb_ld(&bar[XB_TOPGEN]) == tg, bar);
            __builtin_amdgcn_fence(__ATOMIC_ACQUIRE, "agent");
            xb_add(&bar[XB_XGEN(b.x)], 1u);
            asm volatile("s_waitcnt vmcnt(0)" ::: "memory");
        } else {
            XB_SPIN(xb_ld(&bar[XB_XGEN(b.x)]) == gen, bar);
            __builtin_amdgcn_fence(__ATOMIC_ACQUIRE, "agent");
            asm volatile("s_waitcnt vmcnt(0)" ::: "memory");
        }
    }
    __syncthreads();
}

constexpr int NWAVES = 8;
constexpr int D = 4096, BATCH = 4, SEQ = 2048, NMETA = 16, TP = SEQ + NMETA, MPROMPT = BATCH * TP;
constexpr int DEC_B = 128, DEC_T = 4, MSAMP = DEC_B * DEC_T, MTOT = MPROMPT + MSAMP, MP = 8960;
constexpr int MC = BATCH * SEQ + MSAMP;
constexpr int GH = 4, DK = 256, DV = 512, QK = 1024, GW = 2048, RANK = 16;
constexpr int SW = 2048, HD = 64, SH = 32, SG = 8, NS = 128, CONV_DIM = 4096;
constexpr int DFF = 16384, DIN = 12336;
constexpr int NU = 12288, NIN_PAD = 12544;
constexpr int UC_Q = 0, UC_K = 1024, UC_V = 2048, UC_R = 4096, UC_Z = 6144, UC_XBC = 8192;
constexpr float ALPHA = 1.189207115002721f, EPS = 1e-5f;

constexpr size_t MiB = 1u << 20;
constexpr size_t WS_CTL = 0, CTL_ZERO_BYTES = 32768;
constexpr size_t WS_WIN = 1 * MiB, WS_WOUT = 99 * MiB, WS_WUP = 131 * MiB, WS_WDN = 259 * MiB;
constexpr size_t WS_XB = 387 * MiB;
constexpr size_t WS_U = 457 * MiB, WS_UT = 667 * MiB, WS_EG = 670 * MiB, WS_DTA = 705 * MiB, WS_XC = 708 * MiB, WS_OY = 845 * MiB;
constexpr size_t WS_MIX = 982 * MiB, WS_HB = 1052 * MiB, WS_END = 1122 * MiB;
constexpr size_t WS_GIMG = WS_MIX;
constexpr size_t WS_PRE1 = WS_XC;
constexpr size_t WS_PRE2 = WS_MIX;
constexpr size_t WS_SLAB = WS_OY;
constexpr size_t WS_HID = WS_U;
static_assert(WS_WIN + (size_t)NIN_PAD * D * 2 <= WS_WOUT && WS_XB + (size_t)MP * D * 2 <= WS_U && WS_U + (size_t)MP * NU * 2 <= WS_UT && WS_UT + (size_t)MP * 64 * 4 <= WS_EG, "ws map 1");
static_assert(WS_EG + (size_t)MTOT * 1024 * 4 <= WS_DTA && WS_DTA + (size_t)MTOT * 64 * 4 <= WS_XC && WS_XC + (size_t)MTOT * D * 4 <= WS_OY && WS_OY + (size_t)MTOT * D * 4 <= WS_MIX  , "ws map 2");
static_assert(WS_MIX + (size_t)MP * D * 2 <= WS_HB && WS_HB + (size_t)MP * D * 2 <= WS_END && WS_HID + (size_t)MP * DFF * 2 <= WS_OY, "ws map 3");
constexpr int CW_TMO = 0, CW_Q = 64, CW_CV0 = 256, CW_CV1 = 320, CW_P2Q = 384, CW_BAR = 4096;
static_assert((CW_BAR + 3456) * 4 <= (int)CTL_ZERO_BYTES, "control words inside the per-launch memset");

constexpr size_t O_YP = 0, O_YS = O_YP + (size_t)BATCH * SEQ * D, O_GP = O_YS + (size_t)MSAMP * D, O_SP = O_GP + (size_t)BATCH * GH * DK * DV,
                 O_CP = O_SP + (size_t)BATCH * SH * HD * NS, O_GS = O_CP + (size_t)BATCH * 3 * CONV_DIM, O_SS = O_GS + (size_t)DEC_B * GH * DK * DV,
                 O_CS = O_SS + (size_t)DEC_B * SH * HD * NS, O_END = O_CS + (size_t)DEC_B * 3 * CONV_DIM;

constexpr int RING_OFF = 0, RING_BYTES = 131072;
constexpr int LDSCTL_OFF = 157696, MISC_OFF = LDSCTL_OFF + 320;
constexpr int LDS_BYTES = LDSCTL_OFF + 1024;

typedef float f32x2 __attribute__((ext_vector_type(2)));
__device__ __forceinline__ float bf_lo(unsigned w) { return __uint_as_float(w << 16); }
__device__ __forceinline__ float bf_hi(unsigned w) { return __uint_as_float(w & 0xffff0000u); }
template <int CTRL> __device__ __forceinline__ float dppf(float x) { return __builtin_bit_cast(float, __builtin_amdgcn_update_dpp(0, __builtin_bit_cast(int, x), CTRL, 0xf, 0xf, false)); }
__device__ __forceinline__ float row_allreduce(float x) { x += dppf<0x128>(x); x += dppf<0x124>(x); x += dppf<0x122>(x); x += dppf<0x121>(x); return x; }
__device__ __forceinline__ float half_row_allreduce(float x) { x += dppf<0x141>(x); x += dppf<0x4E>(x); x += dppf<0xB1>(x); return x; }
__device__ __forceinline__ void swap16(float& a, float& b) { asm("s_nop 1\n\tv_permlane16_swap_b32 %0, %1" : "+v"(a), "+v"(b)); }
__device__ __forceinline__ void swap32(float& a, float& b) { asm("s_nop 1\n\tv_permlane32_swap_b32 %0, %1" : "+v"(a), "+v"(b)); }
__device__ __forceinline__ float wave_sum(float v) { v = row_allreduce(v); float a = v, b = v; swap16(a, b); v = a + b; a = v; b = v; swap32(a, b); return a + b; }
__device__ __forceinline__ float silu_f(float x) { return x * __builtin_amdgcn_rcpf(1.f + __expf(-x)); }
__device__ __forceinline__ float softplus_f(float x) { return fmaxf(x, 0.f) + __logf(1.f + __expf(-fabsf(x))); }

struct Args { const float* in[23]; float* out; unsigned char* ws; int ph_lo, ph_hi; };
__device__ __forceinline__ int opaque_lane(int tid) { int l; asm volatile("v_and_b32 %0, 63, %1" : "=v"(l) : "v"(tid)); return l; }

__device__ __forceinline__ void transpose_item(const float* W, int ldw, int K, int k0, int nsrc, bf16* WT, int ndst, int nvalid, LAS float* scr, int lane) {
    float wv[32];
#pragma unroll
    for (int i = 0; i < 32; ++i) { const int kk = 2 * i + (lane >> 5); wv[i] = __builtin_nontemporal_load(W + (size_t)(k0 + kk) * ldw + nsrc + (lane & 31)); }
#pragma unroll
    for (int i = 0; i < 32; ++i) { const int kk = 2 * i + (lane >> 5); scr[kk * 33 + (lane & 31)] = wv[i]; }
    LDS_WAIT(); asm volatile("" ::: "memory");
    const int c = lane & 7;
#pragma unroll
    for (int j = 0; j < 4; ++j) { const int n = (lane >> 3) + 8 * j; const LAS float* s = scr + (8 * c) * 33 + n;
        v4u o; o.x = pk2(s[0 * 33], s[1 * 33]); o.y = pk2(s[2 * 33], s[3 * 33]); o.z = pk2(s[4 * 33], s[5 * 33]); o.w = pk2(s[6 * 33], s[7 * 33]);
        if (n < nvalid) __builtin_nontemporal_store(o, (GAS v4u*)(WT + (size_t)(ndst + n) * K + k0 + 8 * c)); }
    LDS_WAIT(); asm volatile("" ::: "memory");
}
__device__ __forceinline__ void p0_prologue(const Args& A, LAS unsigned char* lds, int tid, int lane, int wave, int G) {
    unsigned char* ws = A.ws;
    bf16* WIN = (bf16*)(ws + WS_WIN); bf16* XB = (bf16*)(ws + WS_XB);
    const float* w_in = A.in[6];
    LAS float* scr = (LAS float*)(lds + RING_OFF + wave * 16384);
    const int gw = wave * G + blockIdx.x, NGW = G * NWAVES;
    constexpr int NB_IN = 386, I_IN = (D / 64) * NB_IN;
#define P0_DECODE(it, k0, nsrc, ndst, nv) do { const int kb_ = (it) / NB_IN, nb_ = (it) - kb_ * NB_IN; k0 = 64 * kb_; nv = 32; \
        if (nb_ < 192) { nsrc = 32 * nb_; ndst = nsrc; } else if (nb_ == 192) { nsrc = 6144; ndst = 12288; nv = 16; } else if (nb_ < 385) { nsrc = 6160 + 32 * (nb_ - 193); ndst = 6144 + 32 * (nb_ - 193); } else { nsrc = 12304; ndst = 12304; } } while (0)
#define P0_LOAD(dst, k0, nsrc) do { _Pragma("unroll") for (int i = 0; i < 32; ++i) dst[i] = __builtin_nontemporal_load(w_in + (size_t)((k0) + 2 * i + (lane >> 5)) * DIN + (nsrc) + (lane & 31)); } while (0)
    if (gw < I_IN) {
        float wv[32], wn[32]; int k0, nsrc, ndst, nv;
        P0_DECODE(gw, k0, nsrc, ndst, nv); P0_LOAD(wv, k0, nsrc);
        for (int it = gw; it < I_IN; it += NGW) {
            const int itn = it + NGW < I_IN ? it + NGW : it; int k0n, nsrcn, ndstn, nvn;
            P0_DECODE(itn, k0n, nsrcn, ndstn, nvn); P0_LOAD(wn, k0n, nsrcn);
#pragma unroll
            for (int i = 0; i < 32; ++i) scr[(2 * i + (lane >> 5)) * 33 + (lane & 31)] = wv[i];
            LDS_WAIT(); asm volatile("" ::: "memory");
            const int c = lane & 7;
#pragma unroll
            for (int j = 0; j < 4; ++j) { const int n = (lane >> 3) + 8 * j; const LAS float* sp = scr + (8 * c) * 33 + n;
                v4u o; o.x = pk2(sp[0 * 33], sp[1 * 33]); o.y = pk2(sp[2 * 33], sp[3 * 33]); o.z = pk2(sp[4 * 33], sp[5 * 33]); o.w = pk2(sp[6 * 33], sp[7 * 33]);
                if (n < nv) *(GAS v4u*)(WIN + (size_t)(ndst + n) * D + k0 + 8 * c) = o; }
            LDS_WAIT(); asm volatile("" ::: "memory");
#pragma unroll
            for (int i = 0; i < 32; ++i) wv[i] = wn[i];
            k0 = k0n; nsrc = nsrcn; ndst = ndstn; nv = nvn;
        }
    }
#undef P0_DECODE
#undef P0_LOAD
    { const size_t n16 = (size_t)(NIN_PAD - DIN) * D * 2 / 16; GAS v4u* z = (GAS v4u*)(WIN + (size_t)DIN * D);
      for (size_t i = (size_t)blockIdx.x * 512 + tid; i < n16; i += (size_t)G * 512) z[i] = (v4u){0u, 0u, 0u, 0u}; }
    pg8::RowMap rm{A.in[0], A.in[1], A.in[5], nullptr, TP, NMETA, SEQ, MPROMPT, MTOT, D};
    for (int r = gw; r < MP; r += NGW) {
        GAS unsigned long long* o8 = (GAS unsigned long long*)(XB + (size_t)r * D) + lane;
        if (r < MTOT) { const GAS f32x4* xr = (const GAS f32x4*)rm.src(r) + lane;
#pragma unroll 8
            for (int j = 0; j < 16; ++j) { const f32x4 v = __builtin_nontemporal_load(xr + 64 * j); o8[64 * j] = (unsigned long long)pk2(v.x, v.y) | ((unsigned long long)pk2(v.z, v.w) << 32); } }
        else {
#pragma unroll 4
            for (int j = 0; j < 16; ++j) o8[64 * j] = 0ull; }
    }
}

constexpr int CV_OUT = (D / 64) * (D / 32), CV_UP = (D / 64) * (DFF / 32), CV_DN = (DFF / 64) * (D / 32), CV_BATCH = 4;
__device__ __forceinline__ void convert_queue(const Args& A, LAS unsigned char* lds, int lane, int wave, gu32* ctr, int which) {
    unsigned char* ws = A.ws;
    bf16* WOUT = (bf16*)(ws + WS_WOUT); bf16* WUP = (bf16*)(ws + WS_WUP); bf16* WDN = (bf16*)(ws + WS_WDN);
    const float* w_out = A.in[16]; const float* w_up = A.in[19]; const float* w_down = A.in[20];
    LAS float* scr = (LAS float*)(lds + RING_OFF + wave * 16384);
    const int nitems = which == 0 ? CV_OUT + CV_UP : CV_DN;
    for (;;) {
        unsigned b0 = 0u; if (lane == 0) b0 = __hip_atomic_fetch_add((unsigned*)ctr, 1u, __ATOMIC_RELAXED, __HIP_MEMORY_SCOPE_AGENT);
        const int base = (int)__builtin_amdgcn_readfirstlane(b0) * CV_BATCH;
        if (base >= nitems) break;
        for (int q = 0; q < CV_BATCH; ++q) { int r = base + q;
            if (which == 0) {
                if (r < CV_OUT) { const int kb = r / (D / 32), nb = r - kb * (D / 32); transpose_item(w_out, D, D, 64 * kb, 32 * nb, WOUT, 32 * nb, 32, scr, lane); }
                else { r -= CV_OUT; const int kb = r / (DFF / 32), nb = r - kb * (DFF / 32); transpose_item(w_up, DFF, D, 64 * kb, 32 * nb, WUP, 32 * nb, 32, scr, lane); }
            } else { const int kb = r / (D / 32), nb = r - kb * (D / 32); transpose_item(w_down, D, DFF, 64 * kb, 32 * nb, WDN, 32 * nb, 32, scr, lane); } }
    }
}

__device__ __forceinline__ void gla_image_unit(const Args& A, LAS unsigned char* lds, int tid, int b, int h, int c);
__device__ __forceinline__ void p2_prepass(const Args& A, LAS unsigned char* lds, int tid, int G, gu32* ctl, volatile LAS unsigned* MISC) {
    unsigned char* ws = A.ws;
    const bf16* U = (const bf16*)(ws + WS_U); const float* UT = (const float*)(ws + WS_UT); float* EG = (float*)(ws + WS_EG); float* DTA = (float*)(ws + WS_DTA); bf16* XC = (bf16*)(ws + WS_XC);
    const float* state_conv = A.in[4]; const float* w_gk_up = A.in[7]; const float* b_gk = A.in[8]; const float* conv_w = A.in[10]; const float* conv_b = A.in[11];
    const float* dt_bias = A.in[12]; const float* a_log = A.in[13];
    LAS float* uts = (LAS float*)(lds + RING_OFF);
    float wg0[RANK], wg1[RANK];
#pragma unroll
    for (int j = 0; j < RANK; ++j) { const f32x2 w = *(const f32x2*)(w_gk_up + j * QK + 2 * tid); wg0[j] = w.x; wg1[j] = w.y; }
    const f32x2 bg = *(const f32x2*)(b_gk + 2 * tid);
    float cw[4][8], cb[8];
#pragma unroll
    for (int j = 0; j < 4; ++j) { const f32x4 a = *(const f32x4*)(conv_w + j * CONV_DIM + 8 * tid), b = *(const f32x4*)(conv_w + j * CONV_DIM + 8 * tid + 4);
        cw[j][0] = a.x; cw[j][1] = a.y; cw[j][2] = a.z; cw[j][3] = a.w; cw[j][4] = b.x; cw[j][5] = b.y; cw[j][6] = b.z; cw[j][7] = b.w; }
    { const f32x4 a = *(const f32x4*)(conv_b + 8 * tid), b = *(const f32x4*)(conv_b + 8 * tid + 4); cb[0] = a.x; cb[1] = a.y; cb[2] = a.z; cb[3] = a.w; cb[4] = b.x; cb[5] = b.y; cb[6] = b.z; cb[7] = b.w; }
    const int hd = tid & 31; const float dtb = dt_bias[hd], aneg = -expf(a_log[hd]);
    constexpr int NRUN_P = BATCH * (TP / 16), NUNITS = NRUN_P + DEC_B;
    static_assert(TP % 16 == 0, "prompt runs");
    constexpr int NIMG = BATCH * 4 * ((TP + 63) / 64);
    unsigned qnext = 0u; if (tid == 0) qnext = __hip_atomic_fetch_add((unsigned*)(ctl + CW_P2Q), 1u, __ATOMIC_RELAXED, __HIP_MEMORY_SCOPE_AGENT);
    for (;;) {
        if (tid == 0) MISC[1] = qnext;
        __syncthreads(); const int it0 = (int)MISC[1]; __syncthreads();
        if (it0 >= NIMG + NRUN_P + DEC_B) break;
        if (tid == 0) qnext = __hip_atomic_fetch_add((unsigned*)(ctl + CW_P2Q), 1u, __ATOMIC_RELAXED, __HIP_MEMORY_SCOPE_AGENT);
        if (it0 < NIMG) { const int nck = (TP + 63) / 64, bh = (it0 & 7) + 8 * ((it0 >> 3) / nck), c = (it0 >> 3) % nck; gla_image_unit(A, lds, tid, bh >> 2, bh & 3, c); continue; }
        const int u = it0 - NIMG; const bool doB = true, doA = u >= NRUN_P;
        int r0, t0, L, rseq; const float* hist = nullptr;
        if (u < NRUN_P) { const int b = u / (TP / 16), c = u - b * (TP / 16); rseq = b * TP; t0 = 16 * c; r0 = rseq + t0; L = 16; }
        else { const int s = u - NRUN_P; rseq = MPROMPT + 4 * s; t0 = 0; r0 = rseq; L = 4; hist = state_conv + (size_t)s * 3 * CONV_DIM; }
        if (doA) {
        for (int i = tid; i < L * 64; i += 512) uts[i] = UT[(size_t)r0 * 64 + i];
        __syncthreads();
        { float c0s = 0.f, c1s = 0.f;
#pragma unroll 2
          for (int i = 0; i < L; ++i) { float z0 = bg.x, z1 = bg.y;
            const f32x4 u0 = *(const LAS f32x4*)(uts + i * 64), u1 = *(const LAS f32x4*)(uts + i * 64 + 4), u2 = *(const LAS f32x4*)(uts + i * 64 + 8), u3 = *(const LAS f32x4*)(uts + i * 64 + 12);
            const float ux[RANK] = {u0.x, u0.y, u0.z, u0.w, u1.x, u1.y, u1.z, u1.w, u2.x, u2.y, u2.z, u2.w, u3.x, u3.y, u3.z, u3.w};
#pragma unroll
            for (int j = 0; j < RANK; ++j) { z0 += ux[j] * wg0[j]; z1 += ux[j] * wg1[j]; }
            const float g0 = -softplus_f(-z0) * (1.f / 16.f), g1 = -softplus_f(-z1) * (1.f / 16.f); c0s += g0; c1s += g1;
            f32x2 e; if (hist) { e.x = expf(g0); e.y = expf(g1); } else { e.x = c0s; e.y = c1s; }
            *(f32x2*)(EG + (size_t)(r0 + i) * QK + 2 * tid) = e; } }
        if (hist) { if (tid < 32 * L) { const int i = tid >> 5; const float dt = softplus_f(uts[i * 64 + 16 + hd] + dtb); DTA[(size_t)(r0 + i) * 64 + hd] = dt; DTA[(size_t)(r0 + i) * 64 + 32 + hd] = expf(dt * aneg); } }
        else if (tid < 32) { float cs = 0.f; for (int i = 0; i < L; ++i) { const float dt = softplus_f(uts[i * 64 + 16 + hd] + dtb); cs += dt * aneg; DTA[(size_t)(r0 + i) * 64 + hd] = dt; DTA[(size_t)(r0 + i) * 64 + 32 + hd] = cs; } }
        }
        if (!doA && tid < 32) {
            float dv[16];
#pragma unroll
            for (int i = 0; i < 16; ++i) dv[i] = UT[(size_t)(r0 + i) * 64 + 16 + hd];
            float cs = 0.f;
#pragma unroll
            for (int i = 0; i < 16; ++i) { const float dt = softplus_f(dv[i] + dtb); cs += dt * aneg; DTA[(size_t)(r0 + i) * 64 + hd] = dt; DTA[(size_t)(r0 + i) * 64 + 32 + hd] = cs; } }
        if (doB) { float xh[3][8];
#pragma unroll
          for (int j = 0; j < 3; ++j) { const int tau = t0 - 3 + j;
              if (tau >= 0) { const v4u w = *(const v4u*)(U + (size_t)(rseq + tau) * NU + UC_XBC + 8 * tid);
                  xh[j][0] = bf_lo(w.x); xh[j][1] = bf_hi(w.x); xh[j][2] = bf_lo(w.y); xh[j][3] = bf_hi(w.y); xh[j][4] = bf_lo(w.z); xh[j][5] = bf_hi(w.z); xh[j][6] = bf_lo(w.w); xh[j][7] = bf_hi(w.w); }
              else if (hist) { const f32x4 a = *(const f32x4*)(hist + (size_t)(3 + tau) * CONV_DIM + 8 * tid), b = *(const f32x4*)(hist + (size_t)(3 + tau) * CONV_DIM + 8 * tid + 4);
                  xh[j][0] = a.x; xh[j][1] = a.y; xh[j][2] = a.z; xh[j][3] = a.w; xh[j][4] = b.x; xh[j][5] = b.y; xh[j][6] = b.z; xh[j][7] = b.w; }
              else {
#pragma unroll
                  for (int e = 0; e < 8; ++e) xh[j][e] = 0.f; } }
          const bf16* urow = U + (size_t)r0 * NU + UC_XBC + 8 * tid; v4u wc[4], wn[4];
#pragma unroll
          for (int q = 0; q < 4; ++q) wc[q] = *(const v4u*)(urow + (size_t)q * NU);
          for (int i0 = 0; i0 < L; i0 += 4) { const int in = (i0 + 4 < L) ? i0 + 4 : i0;
#pragma unroll
              for (int q = 0; q < 4; ++q) wn[q] = *(const v4u*)(urow + (size_t)(in + q) * NU);
#pragma unroll
              for (int q = 0; q < 4; ++q) { const v4u w = wc[q]; float x3[8];
                  x3[0] = bf_lo(w.x); x3[1] = bf_hi(w.x); x3[2] = bf_lo(w.y); x3[3] = bf_hi(w.y); x3[4] = bf_lo(w.z); x3[5] = bf_hi(w.z); x3[6] = bf_lo(w.w); x3[7] = bf_hi(w.w);
                  float o[8];
#pragma unroll
                  for (int e = 0; e < 8; ++e) { const float v = cb[e] + cw[0][e] * xh[0][e] + cw[1][e] * xh[1][e] + cw[2][e] * xh[2][e] + cw[3][e] * x3[e]; o[e] = silu_f(v); xh[0][e] = xh[1][e]; xh[1][e] = xh[2][e]; xh[2][e] = x3[e]; }
                  v4u ow; ow.x = pk2(o[0], o[1]); ow.y = pk2(o[2], o[3]); ow.z = pk2(o[4], o[5]); ow.w = pk2(o[6], o[7]); *(v4u*)(XC + (size_t)(r0 + i0 + q) * CONV_DIM + 8 * tid) = ow; }
#pragma unroll
              for (int q = 0; q < 4; ++q) wc[q] = wn[q]; } }
    }
    for (int u = blockIdx.x; u < (BATCH + DEC_B) * 3; u += G) { const int sq = u / 3, i = u - 3 * sq; int r; float* o;
        if (sq < BATCH) { r = sq * TP + TP - 3 + i; o = A.out + O_CP + (size_t)(sq * 3 + i) * CONV_DIM; } else { const int s = sq - BATCH; r = MPROMPT + 4 * s + 1 + i; o = A.out + O_CS + (size_t)(s * 3 + i) * CONV_DIM; }
        const v4u w = *(const v4u*)(U + (size_t)r * NU + UC_XBC + 8 * tid);
        *(f32x4*)(o + 8 * tid) = (f32x4){bf_lo(w.x), bf_hi(w.x), bf_lo(w.y), bf_hi(w.y)}; *(f32x4*)(o + 8 * tid + 4) = (f32x4){bf_lo(w.z), bf_hi(w.z), bf_lo(w.w), bf_hi(w.w)}; }
}

typedef short bf16x8v __attribute__((ext_vector_type(8)));
constexpr int GC = 64, GVS = 64, QT_LD = 264, KH_LD = 72, VT_LD = 72, AS_LD = 72, ST_LD = 264;
constexpr int GL_QT = 0, GL_DL = GL_QT + GC * QT_LD * 2, GL_KH = GL_DL + 1024, GL_AS = GL_KH + 256 * KH_LD * 2, GL_VT = GL_AS + GC * AS_LD * 2, GL_ST = GL_VT + GVS * VT_LD * 2, GL_END = GL_ST + GVS * ST_LD * 2;
constexpr int GIMG_BYTES = GL_VT, GIMG_A = GL_DL, GIMG_B = GL_VT - GL_DL, NCHUNK = (TP + GC - 1) / GC;
static_assert(GL_END <= LDSCTL_OFF && GIMG_A % 1024 == 0 && GIMG_B % 1024 == 0, "GLA LDS map");
__device__ __forceinline__ f32x4 mfma16(bf16x8v a, bf16x8v b, f32x4 c) { return __builtin_amdgcn_mfma_f32_16x16x32_bf16(a, b, c, 0, 0, 0); }
constexpr int GI_BL = GL_KH, GI_KT = GI_BL + GC * 256 * 4, GI_UT = GI_KT + GC * QT_LD * 2;
static_assert(GI_UT + GC * 16 * 4 <= LDSCTL_OFF && GI_BL + GC * 256 * 4 >= GL_VT, "image unit LDS map");
__device__ __forceinline__ void gla_image_unit(const Args& A, LAS unsigned char* lds, int tid, int b, int h, int c) {
    unsigned char* ws = A.ws;
    const bf16* U = (const bf16*)(ws + WS_U); const float* UT = (const float*)(ws + WS_UT);
    LAS bf16* Qt = (LAS bf16*)(lds + GL_QT); LAS bf16* Kt = (LAS bf16*)(lds + GI_KT); LAS bf16* KHt = (LAS bf16*)(lds + GL_KH); LAS float* DL = (LAS float*)(lds + GL_DL); LAS bf16* As = (LAS bf16*)(lds + GL_AS);
    LAS float* BL = (LAS float*)(lds + GI_BL); LAS float* uts = (LAS float*)(lds + GI_UT);
    const int koct = tid & 31, trow = tid >> 5, rb = b * TP + c * GC, nvalid = (TP - c * GC) < GC ? (TP - c * GC) : GC;
    v4u qra[4], kra[4];
#pragma unroll
    for (int i = 0; i < 4; ++i) { const bf16* up = U + (size_t)(rb + trow + 16 * i) * NU + h * DK + 8 * koct; qra[i] = *(const v4u*)(up + UC_Q); kra[i] = *(const v4u*)(up + UC_K); }
    float wk[RANK];
#pragma unroll
    for (int j = 0; j < RANK; ++j) wk[j] = A.in[7][j * QK + h * DK + (tid & 255)];
    const float bgk = A.in[8][h * DK + (tid & 255)];
    if (tid < 256) *(LAS f32x4*)(uts + 4 * tid) = *(const f32x4*)(UT + (size_t)(rb + (tid >> 2)) * 64 + 4 * (tid & 3));
    __syncthreads();
    { const int k = tid & 255, half = tid >> 8;
#pragma unroll
      for (int rr = 0; rr < 2; ++rr) { float cs = 0.f;
#pragma unroll 4
          for (int i = 0; i < 16; ++i) { const int t = 32 * half + 16 * rr + i;
              const f32x4 u0 = *(const LAS f32x4*)(uts + t * 16), u1 = *(const LAS f32x4*)(uts + t * 16 + 4), u2 = *(const LAS f32x4*)(uts + t * 16 + 8), u3 = *(const LAS f32x4*)(uts + t * 16 + 12);
              const float ux[RANK] = {u0.x, u0.y, u0.z, u0.w, u1.x, u1.y, u1.z, u1.w, u2.x, u2.y, u2.z, u2.w, u3.x, u3.y, u3.z, u3.w};
              float z = bgk;
#pragma unroll
              for (int j = 0; j < RANK; ++j) z += ux[j] * wk[j];
              cs += -softplus_f(-z) * (1.f / 16.f); BL[t * 256 + k] = cs; } } }
    __syncthreads();
    { f32x4 p0 = (f32x4){0.f, 0.f, 0.f, 0.f}, p1 = p0;
#pragma unroll
      for (int i = 0; i < 4; ++i) { const int t = trow + 16 * i; const bool ok = t < nvalid; const size_t row = (size_t)(rb + t);
          const LAS float* e = BL + t * 256 + 8 * koct; const f32x4 b0 = *(const LAS f32x4*)e + p0, b1 = *(const LAS f32x4*)(e + 4) + p1;
          const LAS float* pe = BL + (16 * i + 15) * 256 + 8 * koct; const f32x4 pr0 = *(const LAS f32x4*)pe, pr1 = *(const LAS f32x4*)(pe + 4);
          const v4u qr = qra[i], kr = kra[i];
          float eb[8], en[8]; const float bb[8] = {b0.x, b0.y, b0.z, b0.w, b1.x, b1.y, b1.z, b1.w};
#pragma unroll
          for (int e2 = 0; e2 < 8; ++e2) { eb[e2] = __expf(bb[e2]); en[e2] = __builtin_amdgcn_rcpf(eb[e2]); }
          const float qf[8] = {bf_lo(qr.x), bf_hi(qr.x), bf_lo(qr.y), bf_hi(qr.y), bf_lo(qr.z), bf_hi(qr.z), bf_lo(qr.w), bf_hi(qr.w)};
          const float kf[8] = {bf_lo(kr.x), bf_hi(kr.x), bf_lo(kr.y), bf_hi(kr.y), bf_lo(kr.z), bf_hi(kr.z), bf_lo(kr.w), bf_hi(kr.w)};
          v4u qo, ko;
          qo.x = pk2(qf[0] * eb[0] * 0.0625f, qf[1] * eb[1] * 0.0625f); qo.y = pk2(qf[2] * eb[2] * 0.0625f, qf[3] * eb[3] * 0.0625f); qo.z = pk2(qf[4] * eb[4] * 0.0625f, qf[5] * eb[5] * 0.0625f); qo.w = pk2(qf[6] * eb[6] * 0.0625f, qf[7] * eb[7] * 0.0625f);
          ko.x = pk2(kf[0] * en[0], kf[1] * en[1]); ko.y = pk2(kf[2] * en[2], kf[3] * en[3]); ko.z = pk2(kf[4] * en[4], kf[5] * en[5]); ko.w = pk2(kf[6] * en[6], kf[7] * en[7]);
          if (!ok) { qo = (v4u){0u, 0u, 0u, 0u}; ko = qo; }
          *(LAS v4u*)(Qt + t * QT_LD + 8 * koct) = qo; *(LAS v4u*)(Kt + t * QT_LD + 8 * koct) = ko;
          if (16 * (i + 1) <= nvalid) { p0 = p0 + pr0; p1 = p1 + pr1; } }
      if (trow == 0) { *(LAS f32x4*)(DL + 8 * koct) = (f32x4){__expf(p0.x), __expf(p0.y), __expf(p0.z), __expf(p0.w)}; *(LAS f32x4*)(DL + 8 * koct + 4) = (f32x4){__expf(p1.x), __expf(p1.y), __expf(p1.z), __expf(p1.w)}; } }
    if (tid < 128) { *(LAS unsigned long long*)((LAS unsigned char*)Qt + (tid >> 1) * (QT_LD * 2) + 512 + 8 * (tid & 1)) = 0ull; *(LAS unsigned long long*)((LAS unsigned char*)Kt + (tid >> 1) * (QT_LD * 2) + 512 + 8 * (tid & 1)) = 0ull; }
    __syncthreads();
#pragma unroll
    for (int i = 0; i < 4; ++i) { const int idx = tid + 512 * i, k = idx & 255, toct = idx >> 8; unsigned short e[8];
#pragma unroll
        for (int jj = 0; jj < 8; ++jj) e[jj] = Kt[(8 * toct + jj) * QT_LD + k];
        v4u o; o.x = (unsigned)e[0] | ((unsigned)e[1] << 16); o.y = (unsigned)e[2] | ((unsigned)e[3] << 16); o.z = (unsigned)e[4] | ((unsigned)e[5] << 16); o.w = (unsigned)e[6] | ((unsigned)e[7] << 16);
        *(LAS v4u*)(KHt + k * KH_LD + 8 * toct) = o; }
    if (tid < 256) *(LAS v4u*)(KHt + tid * KH_LD + 64) = (v4u){0u, 0u, 0u, 0u};
    { const int lane = tid & 63, w = tid >> 6, r16 = lane & 15, g4 = lane >> 4, ti = w >> 1, sb = 2 * (w & 1);
      f32x4 sc0 = (f32x4){0.f, 0.f, 0.f, 0.f}, sc1 = sc0;
      const LAS bf16* qrow = Qt + (16 * ti + r16) * QT_LD + 8 * g4; const LAS bf16* k0row = Kt + (16 * sb + r16) * QT_LD + 8 * g4; const LAS bf16* k1row = k0row + 16 * QT_LD;
#pragma unroll
      for (int ks = 0; ks < 8; ++ks) { const bf16x8v qf = *(const LAS bf16x8v*)(qrow + 32 * ks);
          if (sb <= ti) sc0 = mfma16(*(const LAS bf16x8v*)(k0row + 32 * ks), qf, sc0);
          if (sb + 1 <= ti) sc1 = mfma16(*(const LAS bf16x8v*)(k1row + 32 * ks), qf, sc1); }
      const int t = 16 * ti + r16;
#pragma unroll
      for (int q = 0; q < 2; ++q) { const int s0 = 16 * (sb + q) + 4 * g4; const f32x4 d = q ? sc1 : sc0;
          pg8::u32x2 o; o.x = pk2(s0 <= t ? d.x : 0.f, s0 + 1 <= t ? d.y : 0.f); o.y = pk2(s0 + 2 <= t ? d.z : 0.f, s0 + 3 <= t ? d.w : 0.f);
          *(LAS pg8::u32x2*)(As + t * AS_LD + s0) = o; }
      if (tid < 64) *(LAS v4u*)(As + tid * AS_LD + 64) = (v4u){0u, 0u, 0u, 0u}; }
    __syncthreads();
    GAS v4u* img = (GAS v4u*)(ws + WS_GIMG + (size_t)((b * GH + h) * NCHUNK + c) * GIMG_BYTES);
    for (int i = tid; i < GIMG_BYTES / 16; i += 512) img[i] = *(const LAS v4u*)(lds + 16 * i);
    __syncthreads();
}
__device__ __forceinline__ void gla_prompt_unit(const Args& A, LAS unsigned char* lds, int tid, int lane, int w, int b, int h, int vs) {
    unsigned char* ws = A.ws;
    const bf16* U = (const bf16*)(ws + WS_U); bf16* OY = (bf16*)(ws + WS_OY);
    LAS bf16* Qt = (LAS bf16*)(lds + GL_QT); LAS bf16* KHt = (LAS bf16*)(lds + GL_KH); LAS bf16* Vt = (LAS bf16*)(lds + GL_VT);
    LAS bf16* As = (LAS bf16*)(lds + GL_AS); LAS bf16* St = (LAS bf16*)(lds + GL_ST); LAS float* DL = (LAS float*)(lds + GL_DL);
    const int r16 = lane & 15, g4 = lane >> 4;
    f32x4 S[2][4];
#pragma unroll
    for (int i = 0; i < 2; ++i)
#pragma unroll
        for (int j = 0; j < 4; ++j) S[i][j] = (f32x4){0.f, 0.f, 0.f, 0.f};
    for (int i = tid; i < GVS * ST_LD / 2; i += 512) ((LAS unsigned*)St)[i] = 0u;
    const unsigned char* img0 = ws + WS_GIMG + (size_t)((b * GH + h) * NCHUNK) * GIMG_BYTES;
#define GLA_DMA(img, off, nbytes) do { for (int q_ = w; q_ < (nbytes) / 1024; q_ += 8) { \
        const unsigned char* gp_ = (img) + (off) + q_ * 1024 + lane * 16; const unsigned la_ = (unsigned)__builtin_amdgcn_readfirstlane((int)(unsigned)(size_t)(lds + (off) + q_ * 1024)); \
        unsigned m0s_; asm volatile("s_mov_b32 %0, m0\n\ts_mov_b32 m0, %2\n\ts_nop 0\n\tglobal_load_lds_dwordx4 %1, off\n\ts_mov_b32 m0, %0" : "=&s"(m0s_) : "v"(gp_), "s"(la_) : "memory"); } } while (0)
    unsigned short vr[8];
#define GLA_VLOAD(rb) do { _Pragma("unroll") for (int jj = 0; jj < 8; ++jj) vr[jj] = U[(size_t)((rb) + 8 * (tid >> 6) + jj) * NU + UC_V + h * DV + vs * GVS + (tid & 63)]; } while (0)
    GLA_DMA(img0, 0, GIMG_A);
    GLA_VLOAD(b * TP);
    for (int c = 0; c < NCHUNK; ++c) {
        const int rbase = b * TP + c * GC, nvalid = (TP - c * GC) < GC ? (TP - c * GC) : GC;
        const unsigned char* img = img0 + (size_t)c * GIMG_BYTES;
        asm volatile("s_waitcnt vmcnt(8)" ::: "memory"); __syncthreads();
        GLA_DMA(img, GIMG_A, GIMG_B);
        { const int v = tid & 63, toct = tid >> 6; v4u o; const bool ok = 8 * toct < nvalid;
            o.x = (unsigned)vr[0] | ((unsigned)vr[1] << 16); o.y = (unsigned)vr[2] | ((unsigned)vr[3] << 16); o.z = (unsigned)vr[4] | ((unsigned)vr[5] << 16); o.w = (unsigned)vr[6] | ((unsigned)vr[7] << 16);
            if (!ok) o = (v4u){0u, 0u, 0u, 0u};
            *(LAS v4u*)(Vt + v * VT_LD + 8 * toct) = o; }
        GLA_VLOAD(rbase + GC);
        const int ti = w >> 1, vb = 2 * (w & 1);
        f32x4 oacc0 = (f32x4){0.f, 0.f, 0.f, 0.f}, oacc1 = oacc0;
        { const LAS bf16* qrow = Qt + (16 * ti + r16) * QT_LD + 8 * g4; const LAS bf16* s0row = St + (16 * vb + r16) * ST_LD + 8 * g4; const LAS bf16* s1row = s0row + 16 * ST_LD;
#pragma unroll
          for (int ks = 0; ks < 8; ++ks) { const bf16x8v qf = *(const LAS bf16x8v*)(qrow + 32 * ks);
              oacc0 = mfma16(qf, *(const LAS bf16x8v*)(s0row + 32 * ks), oacc0); oacc1 = mfma16(qf, *(const LAS bf16x8v*)(s1row + 32 * ks), oacc1); } }
        asm volatile("s_waitcnt vmcnt(8)" ::: "memory"); __syncthreads();
        if (c + 1 < NCHUNK) GLA_DMA(img + GIMG_BYTES, 0, GIMG_A);
        { const LAS bf16* arow = As + (16 * ti + r16) * AS_LD + 8 * g4; const LAS bf16* v0row = Vt + (16 * vb + r16) * VT_LD + 8 * g4; const LAS bf16* v1row = v0row + 16 * VT_LD;
#pragma unroll
          for (int ks = 0; ks < 2; ++ks) { const bf16x8v af = *(const LAS bf16x8v*)(arow + 32 * ks); oacc0 = mfma16(af, *(const LAS bf16x8v*)(v0row + 32 * ks), oacc0); oacc1 = mfma16(af, *(const LAS bf16x8v*)(v1row + 32 * ks), oacc1); }
          bf16* op = OY + (size_t)(rbase + 16 * ti + 4 * g4) * D + h * DV + vs * GVS + 16 * vb + r16;
          bf16* dump = (bf16*)(ws + WS_HB) + (size_t)tid * 64;
#pragma unroll
          for (int e = 0; e < 4; ++e) { bf16* p = (16 * ti + 4 * g4 + e < nvalid) ? op + (size_t)e * D : dump; p[0] = (bf16)f2bf(oacc0[e]); p[16] = (bf16)f2bf(oacc1[e]); } }
        bf16x8v vf[4][2];
#pragma unroll
        for (int j = 0; j < 4; ++j)
#pragma unroll
            for (int ks = 0; ks < 2; ++ks) vf[j][ks] = *(const LAS bf16x8v*)(Vt + (16 * j + r16) * VT_LD + 8 * g4 + 32 * ks);
#pragma unroll
        for (int i = 0; i < 2; ++i) { const int kt = 2 * w + i; const LAS bf16* krow = KHt + (16 * kt + r16) * KH_LD + 8 * g4; const f32x4 dl = *(const LAS f32x4*)(DL + 16 * kt + 4 * g4);
            const bf16x8v kf0 = *(const LAS bf16x8v*)(krow), kf1 = *(const LAS bf16x8v*)(krow + 32);
#pragma unroll
            for (int j = 0; j < 4; ++j) { f32x4 a = S[i][j];
                a = mfma16(kf0, vf[j][0], a); a = mfma16(kf1, vf[j][1], a);
                a = a * dl; S[i][j] = a;
                pg8::u32x2 o; o.x = pk2(a.x, a.y); o.y = pk2(a.z, a.w);
                *(LAS pg8::u32x2*)(St + (16 * j + r16) * ST_LD + 16 * kt + 4 * g4) = o; } }
    }
#undef GLA_DMA
#undef GLA_VLOAD
    asm volatile("s_waitcnt vmcnt(0)" ::: "memory");
    float* So = A.out + O_GP + ((size_t)(b * GH + h) * DK) * DV + vs * GVS;
#pragma unroll
    for (int i = 0; i < 2; ++i)
#pragma unroll
        for (int j = 0; j < 4; ++j)
#pragma unroll
            for (int e = 0; e < 4; ++e) So[(size_t)(16 * (2 * w + i) + 4 * g4 + e) * DV + 16 * j + r16] = S[i][j][e];
    __syncthreads();
}
constexpr int SC_LD = 136, SX_LD = 72;
constexpr int SL_CM = 0, SL_BM = SL_CM + 64 * SC_LD * 2, SL_BT = SL_BM + 64 * SC_LD * 2, SL_XT = SL_BT + 128 * SX_LD * 2, SL_XH = SL_XT + 64 * SX_LD * 2, SL_WS = SL_XH + 64 * SX_LD * 2, SL_HT = SL_WS + 64 * SX_LD * 2,
              SL_SM = SL_HT + 64 * SC_LD * 2, SL_END = SL_SM + 2 * 4 * 64 * 4;
static_assert(SL_END <= LDSCTL_OFF, "SSD LDS map");
__device__ __forceinline__ void ssd_prompt_unit(const Args& A, LAS unsigned char* lds, int tid, int lane, int w, int b, int head) {
    unsigned char* ws = A.ws;
    const bf16* XC = (const bf16*)(ws + WS_XC); const float* DTA = (const float*)(ws + WS_DTA); bf16* OY = (bf16*)(ws + WS_OY);
    LAS bf16* Cm = (LAS bf16*)(lds + SL_CM); LAS bf16* Bm = (LAS bf16*)(lds + SL_BM); LAS bf16* Bt = (LAS bf16*)(lds + SL_BT); LAS bf16* Xt = (LAS bf16*)(lds + SL_XT); LAS bf16* Xh = (LAS bf16*)(lds + SL_XH);
    LAS bf16* Ws = (LAS bf16*)(lds + SL_WS); LAS bf16* Ht = (LAS bf16*)(lds + SL_HT); LAS float* SM = (LAS float*)(lds + SL_SM);
    const int g = head >> 2, r16 = lane & 15, g4 = lane >> 4;
    const float dskip = A.in[14][head];
    f32x4 H[4];
#pragma unroll
    for (int j = 0; j < 4; ++j) H[j] = (f32x4){0.f, 0.f, 0.f, 0.f};
    for (int i = tid; i < 64 * SC_LD / 2; i += 512) ((LAS unsigned*)Ht)[i] = 0u;
    const int noct = tid & 15, trow = tid >> 4, xp = tid & 63, xso = tid >> 6;
    v4u cr[2], br[2]; unsigned short xr[8];
#define SSD2_LOAD(rb) do { _Pragma("unroll") for (int i = 0; i < 2; ++i) { const bf16* xrow = XC + (size_t)((rb) + trow + 32 * i) * CONV_DIM + SW + g * NS + 8 * noct; \
            br[i] = *(const v4u*)xrow; cr[i] = *(const v4u*)(xrow + SG * NS); } \
        _Pragma("unroll") for (int jj = 0; jj < 8; ++jj) xr[jj] = XC[(size_t)((rb) + 8 * xso + jj) * CONV_DIM + head * HD + xp]; } while (0)
    float s_lc = 0.f, s_dt = 0.f, s_rt[4] = {0.f, 0.f, 0.f, 0.f};
#define SSD2_SCLD(rb) do { if (tid < 64) { const float* dr = DTA + (size_t)(rb) * 64; s_lc = dr[(size_t)tid * 64 + 32 + head]; s_dt = dr[(size_t)tid * 64 + head]; \
            _Pragma("unroll") for (int r = 0; r < 4; ++r) s_rt[r] = dr[(size_t)(16 * r + 15) * 64 + 32 + head]; } } while (0)
#define SSD2_SCST(nv, par) do { if (tid < 64) { const int t = tid; float tot = 0.f, pre = 0.f; \
            _Pragma("unroll") for (int r = 0; r < 4; ++r) { if (16 * (r + 1) <= (nv)) { tot += s_rt[r]; if (r < (t >> 4)) pre += s_rt[r]; } } \
            const bool ok = t < (nv); const float cum = ok ? s_lc + pre : tot, dt = ok ? s_dt : 0.f; \
            LAS float* smw = SM + (par) * 256; smw[t] = cum; smw[64 + t] = dt; smw[128 + t] = __expf(tot - cum) * dt; if (t == 0) smw[192] = __expf(tot); } } while (0)
    SSD2_LOAD(b * TP);
    SSD2_SCLD(b * TP); SSD2_SCST((TP < GC ? TP : GC), 0);
    __syncthreads();
    int par = 0;
    for (int c0 = 0; c0 < TP; c0 += GC, par ^= 1) {
        const int rbase = b * TP + c0, nvalid = (TP - c0) < GC ? (TP - c0) : GC;
        const LAS float* sm = SM + par * 256;
#pragma unroll
        for (int i = 0; i < 2; ++i) { const int t = trow + 32 * i; v4u co = cr[i], bo = br[i];
            if (t >= nvalid) { co = (v4u){0u, 0u, 0u, 0u}; bo = co; }
            *(LAS v4u*)(Cm + t * SC_LD + 8 * noct) = co; *(LAS v4u*)(Bm + t * SC_LD + 8 * noct) = bo; }
        { const f32x4 w0 = *(const LAS f32x4*)(sm + 128 + 8 * xso), w1 = *(const LAS f32x4*)(sm + 128 + 8 * xso + 4); const bool ok = 8 * xso < nvalid; v4u xo, ho;
          xo.x = (unsigned)xr[0] | ((unsigned)xr[1] << 16); xo.y = (unsigned)xr[2] | ((unsigned)xr[3] << 16); xo.z = (unsigned)xr[4] | ((unsigned)xr[5] << 16); xo.w = (unsigned)xr[6] | ((unsigned)xr[7] << 16);
          ho.x = pk2(bf_lo(xo.x) * w0.x, bf_hi(xo.x) * w0.y); ho.y = pk2(bf_lo(xo.y) * w0.z, bf_hi(xo.y) * w0.w); ho.z = pk2(bf_lo(xo.z) * w1.x, bf_hi(xo.z) * w1.y); ho.w = pk2(bf_lo(xo.w) * w1.z, bf_hi(xo.w) * w1.w);
          if (!ok) { xo = (v4u){0u, 0u, 0u, 0u}; ho = xo; }
          *(LAS v4u*)(Xt + xp * SX_LD + 8 * xso) = xo; *(LAS v4u*)(Xh + xp * SX_LD + 8 * xso) = ho; }
        __syncthreads();
        SSD2_LOAD(rbase + GC); SSD2_SCLD(rbase + GC);
#pragma unroll
        for (int i = 0; i < 2; ++i) { const int idx = tid + 512 * i, n = idx & 127, soct = idx >> 7; unsigned short e[8];
#pragma unroll
            for (int jj = 0; jj < 8; ++jj) e[jj] = Bm[(8 * soct + jj) * SC_LD + n];
            v4u o; o.x = (unsigned)e[0] | ((unsigned)e[1] << 16); o.y = (unsigned)e[2] | ((unsigned)e[3] << 16); o.z = (unsigned)e[4] | ((unsigned)e[5] << 16); o.w = (unsigned)e[6] | ((unsigned)e[7] << 16);
            *(LAS v4u*)(Bt + n * SX_LD + 8 * soct) = o; }
        const int ti = w >> 1, sb = 2 * (w & 1);
        f32x4 sc0 = (f32x4){0.f, 0.f, 0.f, 0.f}, sc1 = sc0, y0 = sc0, y1 = sc0;
        { const LAS bf16* crow = Cm + (16 * ti + r16) * SC_LD + 8 * g4; const LAS bf16* b0row = Bm + (16 * sb + r16) * SC_LD + 8 * g4; const LAS bf16* b1row = b0row + 16 * SC_LD;
          const LAS bf16* h0row = Ht + (16 * sb + r16) * SC_LD + 8 * g4; const LAS bf16* h1row = h0row + 16 * SC_LD;
#pragma unroll
          for (int ks = 0; ks < 4; ++ks) { const bf16x8v cf = *(const LAS bf16x8v*)(crow + 32 * ks);
              if (sb <= ti) sc0 = mfma16(*(const LAS bf16x8v*)(b0row + 32 * ks), cf, sc0);
              if (sb + 1 <= ti) sc1 = mfma16(*(const LAS bf16x8v*)(b1row + 32 * ks), cf, sc1);
              y0 = mfma16(cf, *(const LAS bf16x8v*)(h0row + 32 * ks), y0); y1 = mfma16(cf, *(const LAS bf16x8v*)(h1row + 32 * ks), y1); } }
        { const int t = 16 * ti + r16; const float cumt = sm[t];
#pragma unroll
          for (int q = 0; q < 2; ++q) { const int s0 = 16 * (sb + q) + 4 * g4; const f32x4 d = q ? sc1 : sc0; const f32x4 cs = *(const LAS f32x4*)(sm + s0), ds = *(const LAS f32x4*)(sm + 64 + s0);
              float wv[4];
#pragma unroll
              for (int e = 0; e < 4; ++e) { const int s = s0 + e; float v = (s <= t) ? d[e] * __expf(cumt - cs[e]) * ds[e] : 0.f; if (s == t) v += dskip; wv[e] = v; }
              pg8::u32x2 o; o.x = pk2(wv[0], wv[1]); o.y = pk2(wv[2], wv[3]);
              *(LAS pg8::u32x2*)(Ws + t * SX_LD + s0) = o; } }
        { const f32x4 ec = *(const LAS f32x4*)(sm + 16 * ti + 4 * g4);
#pragma unroll
          for (int e = 0; e < 4; ++e) { const float s = __expf(ec[e]); y0[e] *= s; y1[e] *= s; } }
        __syncthreads();
        { const LAS bf16* wrow = Ws + (16 * ti + r16) * SX_LD + 8 * g4; const LAS bf16* x0row = Xt + (16 * sb + r16) * SX_LD + 8 * g4; const LAS bf16* x1row = x0row + 16 * SX_LD;
#pragma unroll
          for (int ks = 0; ks < 2; ++ks) { const bf16x8v wf = *(const LAS bf16x8v*)(wrow + 32 * ks); y0 = mfma16(wf, *(const LAS bf16x8v*)(x0row + 32 * ks), y0); y1 = mfma16(wf, *(const LAS bf16x8v*)(x1row + 32 * ks), y1); }
          bf16* op = OY + (size_t)(rbase + 16 * ti + 4 * g4) * D + GW + head * HD + 16 * sb + r16;
          bf16* dump = (bf16*)(ws + WS_HB) + (size_t)tid * 64;
#pragma unroll
          for (int e = 0; e < 4; ++e) { bf16* p = (16 * ti + 4 * g4 + e < nvalid) ? op + (size_t)e * D : dump; p[0] = (bf16)f2bf(y0[e]); p[16] = (bf16)f2bf(y1[e]); } }
        { const float dl = sm[192]; const LAS bf16* brow = Bt + (16 * w + r16) * SX_LD + 8 * g4;
          const bf16x8v bf0 = *(const LAS bf16x8v*)(brow), bf1 = *(const LAS bf16x8v*)(brow + 32);
#pragma unroll
          for (int j = 0; j < 4; ++j) { const LAS bf16* xrow = Xh + (16 * j + r16) * SX_LD + 8 * g4; f32x4 a = H[j] * dl;
              a = mfma16(bf0, *(const LAS bf16x8v*)(xrow), a); a = mfma16(bf1, *(const LAS bf16x8v*)(xrow + 32), a); H[j] = a;
              pg8::u32x2 o; o.x = pk2_sw(a.x, a.y); o.y = pk2_sw(a.z, a.w);
              *(LAS pg8::u32x2*)(Ht + (16 * j + r16) * SC_LD + 16 * w + 4 * g4) = o; } }
        SSD2_SCST(((TP - c0 - GC) < GC ? (TP - c0 - GC) : GC), par ^ 1);
        __syncthreads();
    }
#undef SSD2_LOAD
#undef SSD2_SCLD
#undef SSD2_SCST
    float* Ho = A.out + O_SP + ((size_t)(b * SH + head) * HD) * NS;
#pragma unroll
    for (int j = 0; j < 4; ++j) *(f32x4*)(Ho + (size_t)(16 * j + r16) * NS + 16 * w + 4 * g4) = H[j];
    __syncthreads();
}
__device__ __forceinline__ void gla_sample_unit(const Args& A, LAS unsigned char* lds, int tid, int lane, int w, int s, int h) {
    unsigned char* ws = A.ws;
    const bf16* U = (const bf16*)(ws + WS_U); const float* EG = (const float*)(ws + WS_EG); bf16* OY = (bf16*)(ws + WS_OY);
    LAS f32x4* Gs = (LAS f32x4*)(lds + RING_OFF); LAS float* Vs = (LAS float*)(lds + RING_OFF + 16384); LAS float* Red = (LAS float*)(lds + RING_OFF + 24576);
    const int rb = MPROMPT + 4 * s;
    const float* Sin = A.in[2] + ((size_t)(s * GH + h) * DK + 32 * w) * DV + 4 * lane; float* Sout = A.out + O_GS + ((size_t)(s * GH + h) * DK + 32 * w) * DV + 4 * lane;
    constexpr int SRB = 4;
    f32x4 cur[SRB][2], nxt[SRB][2], nx2[SRB][2];
#pragma unroll
    for (int u = 0; u < SRB; ++u) { cur[u][0] = *(const f32x4*)(Sin + (size_t)u * DV); cur[u][1] = *(const f32x4*)(Sin + (size_t)u * DV + 256);
                                    nxt[u][0] = *(const f32x4*)(Sin + (size_t)(SRB + u) * DV); nxt[u][1] = *(const f32x4*)(Sin + (size_t)(SRB + u) * DV + 256); }
#pragma unroll
    for (int i = 0; i < 2; ++i) { const int idx = tid + 512 * i, t = idx >> 8, k = idx & 255; const bf16* up = U + (size_t)(rb + t) * NU + h * DK + k;
        Gs[idx] = (f32x4){EG[(size_t)(rb + t) * QK + h * DK + k], __uint_as_float((unsigned)up[UC_K] << 16), __uint_as_float((unsigned)up[UC_Q] << 16) * 0.0625f, 0.f}; }
#pragma unroll
    for (int i = 0; i < 4; ++i) { const int idx = tid + 512 * i, t = idx >> 9, v = idx & 511; Vs[idx] = __uint_as_float((unsigned)U[(size_t)(rb + t) * NU + UC_V + h * DV + v] << 16); }
    __syncthreads();
    f32x4 vr[4][2], acc[4][2];
#pragma unroll
    for (int t = 0; t < 4; ++t) { vr[t][0] = *(const LAS f32x4*)(Vs + t * 512 + 4 * lane); vr[t][1] = *(const LAS f32x4*)(Vs + t * 512 + 256 + 4 * lane); acc[t][0] = (f32x4){0.f, 0.f, 0.f, 0.f}; acc[t][1] = (f32x4){0.f, 0.f, 0.f, 0.f}; }
    for (int kb = 0; kb < 32; kb += SRB) {
        const int kn = (kb + 2 * SRB < 32) ? kb + 2 * SRB : kb;
#pragma unroll
        for (int u = 0; u < SRB; ++u) { nx2[u][0] = *(const f32x4*)(Sin + (size_t)(kn + u) * DV); nx2[u][1] = *(const f32x4*)(Sin + (size_t)(kn + u) * DV + 256); }
#pragma unroll
        for (int u = 0; u < SRB; ++u) { const int k = 32 * w + kb + u;
#pragma unroll
            for (int t = 0; t < 4; ++t) { const f32x4 g4 = Gs[t * 256 + k];
                cur[u][0] = cur[u][0] * g4.x + vr[t][0] * g4.y; cur[u][1] = cur[u][1] * g4.x + vr[t][1] * g4.y;
                acc[t][0] = acc[t][0] + cur[u][0] * g4.z; acc[t][1] = acc[t][1] + cur[u][1] * g4.z; }
            float* q = Sout + (size_t)(kb + u) * DV; *(f32x4*)q = cur[u][0]; *(f32x4*)(q + 256) = cur[u][1]; }
#pragma unroll
        for (int u = 0; u < SRB; ++u) { cur[u][0] = nxt[u][0]; cur[u][1] = nxt[u][1]; nxt[u][0] = nx2[u][0]; nxt[u][1] = nx2[u][1]; }
    }
#pragma unroll
    for (int t = 0; t < 4; ++t) { *(LAS f32x4*)(Red + (w * 4 + t) * 512 + 4 * lane) = acc[t][0]; *(LAS f32x4*)(Red + (w * 4 + t) * 512 + 256 + 4 * lane) = acc[t][1]; }
    __syncthreads();
#pragma unroll
    for (int i = 0; i < 4; ++i) { const int idx = tid + 512 * i, t = idx >> 9, v = idx & 511; float o = 0.f;
#pragma unroll
        for (int ww = 0; ww < 8; ++ww) o += Red[(ww * 4 + t) * 512 + v];
        OY[(size_t)(rb + t) * D + h * DV + v] = (bf16)f2bf(o); }
    __syncthreads();
}
__device__ __forceinline__ void ssd_sample_unit(const Args& A, LAS unsigned char* lds, int tid, int lane, int w, int s, int j) {
    unsigned char* ws = A.ws;
    const bf16* XC = (const bf16*)(ws + WS_XC); const float* DTA = (const float*)(ws + WS_DTA); bf16* OY = (bf16*)(ws + WS_OY);
    LAS float* Bs = (LAS float*)(lds + RING_OFF); LAS float* Cs = Bs + 1024; LAS float* Xs = Cs + 1024; LAS float* DTs = Xs + 2048; LAS float* DAs = DTs + 32; LAS float* Ys = DAs + 32;
    const int rb = MPROMPT + 4 * s;
    const int head = 8 * j + w, gl = w >> 2, pl = lane >> 5, nq = lane & 31;
    const float* Hin = A.in[3] + ((size_t)(s * SH + head) * HD) * NS + 4 * nq; float* Hout = A.out + O_SS + ((size_t)(s * SH + head) * HD) * NS + 4 * nq;
    f32x4 h4[4], hn[4], hn2[4];
#pragma unroll
    for (int u = 0; u < 4; ++u) { h4[u] = *(const f32x4*)(Hin + (size_t)(2 * u + pl) * NS); hn[u] = *(const f32x4*)(Hin + (size_t)(2 * (4 + u) + pl) * NS); }
    if (tid < 128) { const int t = tid >> 5, c8 = tid & 31; const bf16* xr = XC + (size_t)(rb + t) * CONV_DIM; const v4u bw = *(const v4u*)(xr + SW + j * 256 + 8 * c8), cw = *(const v4u*)(xr + SW + SG * NS + j * 256 + 8 * c8);
        *(LAS f32x4*)(Bs + t * 256 + 8 * c8) = (f32x4){bf_lo(bw.x), bf_hi(bw.x), bf_lo(bw.y), bf_hi(bw.y)}; *(LAS f32x4*)(Bs + t * 256 + 8 * c8 + 4) = (f32x4){bf_lo(bw.z), bf_hi(bw.z), bf_lo(bw.w), bf_hi(bw.w)};
        *(LAS f32x4*)(Cs + t * 256 + 8 * c8) = (f32x4){bf_lo(cw.x), bf_hi(cw.x), bf_lo(cw.y), bf_hi(cw.y)}; *(LAS f32x4*)(Cs + t * 256 + 8 * c8 + 4) = (f32x4){bf_lo(cw.z), bf_hi(cw.z), bf_lo(cw.w), bf_hi(cw.w)}; }
    if (tid < 256) { const int t = tid >> 6, c8 = tid & 63; const v4u xw = *(const v4u*)(XC + (size_t)(rb + t) * CONV_DIM + j * 512 + 8 * c8);
        *(LAS f32x4*)(Xs + t * 512 + 8 * c8) = (f32x4){bf_lo(xw.x), bf_hi(xw.x), bf_lo(xw.y), bf_hi(xw.y)}; *(LAS f32x4*)(Xs + t * 512 + 8 * c8 + 4) = (f32x4){bf_lo(xw.z), bf_hi(xw.z), bf_lo(xw.w), bf_hi(xw.w)}; }
    if (tid < 32) { const int t = tid >> 3, hh = tid & 7; DTs[tid] = DTA[(size_t)(rb + t) * 64 + 8 * j + hh]; DAs[tid] = DTA[(size_t)(rb + t) * 64 + 32 + 8 * j + hh]; }
    __syncthreads();
    f32x4 B4[4], C4[4]; float dA[4], dt[4];
#pragma unroll
    for (int t = 0; t < 4; ++t) { B4[t] = *(const LAS f32x4*)(Bs + t * 256 + gl * 128 + 4 * nq); C4[t] = *(const LAS f32x4*)(Cs + t * 256 + gl * 128 + 4 * nq); dA[t] = DAs[t * 8 + w]; dt[t] = DTs[t * 8 + w]; }
    const bool hi8 = (lane & 8) != 0;
    for (int pb = 0; pb < 32; pb += 4) {
        const int pn = (pb + 8 < 32) ? pb + 8 : pb;
#pragma unroll
        for (int u = 0; u < 4; ++u) hn2[u] = *(const f32x4*)(Hin + (size_t)(2 * (pn + u) + pl) * NS);
#pragma unroll
        for (int u = 0; u < 4; ++u) { const int p = 2 * (pb + u) + pl; float y[4];
#pragma unroll
            for (int t = 0; t < 4; ++t) { const float dx = dt[t] * Xs[t * 512 + w * 64 + p]; h4[u] = h4[u] * dA[t] + B4[t] * dx; const f32x4 m = C4[t] * h4[u]; y[t] = (m.x + m.y) + (m.z + m.w); }
            *(f32x4*)(Hout + (size_t)p * NS) = h4[u];
            swap16(y[0], y[1]); const float s01 = y[0] + y[1];
            swap16(y[2], y[3]); const float s23 = y[2] + y[3];
            const float sn = hi8 ? s01 : s23; float kp = hi8 ? s23 : s01;
            kp += dppf<0x128>(sn); kp = half_row_allreduce(kp);
            if ((lane & 7) == 0) Ys[(((lane >> 3) & 1) * 2 + ((lane >> 4) & 1)) * 512 + w * 64 + p] = kp; }
#pragma unroll
        for (int u = 0; u < 4; ++u) { h4[u] = hn[u]; hn[u] = hn2[u]; }
    }
    __syncthreads();
#pragma unroll
    for (int i = 0; i < 4; ++i) { const int idx = tid + 512 * i, t = idx >> 9, c = idx & 511; OY[(size_t)(rb + t) * D + GW + j * 512 + c] = (bf16)f2bf(Ys[idx] + A.in[14][8 * j + (c >> 6)] * Xs[idx]); }
    __syncthreads();
}

#ifndef P3_NPRE
#define P3_NPRE 3
#endif
__device__ __forceinline__ void p3_mixers(const Args& args, LAS unsigned char* lds, int tid, int lane, int wave, int G, gu32* ctl, volatile LAS unsigned* MISC, int qword) {
    constexpr int NGLA = BATCH * GH * (DV / GVS), NSSD = BATCH * SH, NITEMS = 2 * DEC_B * 4;
    if ((int)blockIdx.x < NGLA) {
#pragma unroll 1
        for (int n = 0; n < P3_NPRE; ++n) {
            if (tid == 0) MISC[0] = __hip_atomic_fetch_add((unsigned*)(ctl + qword), 1u, __ATOMIC_RELAXED, __HIP_MEMORY_SCOPE_AGENT);
            __syncthreads(); const int it = (int)MISC[0]; __syncthreads();
            if (it >= NITEMS) break;
            if (it < DEC_B * 4) gla_sample_unit(args, lds, tid, opaque_lane(tid), wave, it >> 2, it & 3);
            else ssd_sample_unit(args, lds, tid, opaque_lane(tid), wave, (it - DEC_B * 4) >> 2, it & 3); } }
    for (int uu = blockIdx.x; uu < NGLA + NSSD; uu += G) {
        if (uu < NGLA) { const int u = uu, bh = (u & 7) + 8 * (u >> 6), vs = (u >> 3) & 7; gla_prompt_unit(args, lds, tid, opaque_lane(tid), wave, bh >> 2, bh & 3, vs); }
        else { const int u = uu - NGLA, q = u >> 3, bg = (u & 7) + 8 * (q >> 2); ssd_prompt_unit(args, lds, tid, opaque_lane(tid), wave, bg >> 3, 4 * (bg & 7) + (q & 3)); } }
    unsigned qnext = 0u; if (tid == 0) qnext = __hip_atomic_fetch_add((unsigned*)(ctl + qword), 1u, __ATOMIC_RELAXED, __HIP_MEMORY_SCOPE_AGENT);
    for (;;) {
        if (tid == 0) MISC[0] = qnext;
        __syncthreads(); const int it = (int)MISC[0]; __syncthreads();
        if (it >= NITEMS) break;
        if (tid == 0) qnext = __hip_atomic_fetch_add((unsigned*)(ctl + qword), 1u, __ATOMIC_RELAXED, __HIP_MEMORY_SCOPE_AGENT);
        if (it < DEC_B * 4) gla_sample_unit(args, lds, tid, opaque_lane(tid), wave, it >> 2, it & 3);
        else ssd_sample_unit(args, lds, tid, opaque_lane(tid), wave, (it - DEC_B * 4) >> 2, it & 3);
    }
}

__device__ __forceinline__ void p4_finalize(const Args& A, int lane, int wave, int G) {
    unsigned char* ws = A.ws;
    const bf16* U = (const bf16*)(ws + WS_U); const bf16* OY = (const bf16*)(ws + WS_OY); bf16* MIX = (bf16*)(ws + WS_MIX);
    const float* gnw = A.in[9]; const float* snw = A.in[15];
    const int gw = wave * G + blockIdx.x, NGW = G * NWAVES;
    const f32x4 w0 = *(const f32x4*)(gnw + 8 * lane), w1 = *(const f32x4*)(gnw + 8 * lane + 4);
    f32x4 wn[SG];
#pragma unroll
    for (int g = 0; g < SG; ++g) wn[g] = *(const f32x4*)(snw + g * 256 + 4 * lane);
#define P4_LOAD(ow_, rw_, yw_, zw_, rc_) do { const int rr_ = (rc_) < BATCH * SEQ ? ((rc_) / SEQ) * TP + NMETA + ((rc_) % SEQ) : (rc_) + BATCH * NMETA;     \
        const bf16* orow_ = OY + (size_t)rr_ * D; const bf16* ur_ = U + (size_t)rr_ * NU; \
        _Pragma("unroll") for (int h = 0; h < GH; ++h) { ow_[h] = *(const v4u*)(orow_ + h * DV + 8 * lane); rw_[h] = *(const v4u*)(ur_ + UC_R + h * DV + 8 * lane); } \
        _Pragma("unroll") for (int g = 0; g < SG; ++g) { yw_[g] = *(const pg8::u32x2*)(orow_ + GW + g * 256 + 4 * lane); zw_[g] = *(const pg8::u32x2*)(ur_ + UC_Z + g * 256 + 4 * lane); } } while (0)
    v4u ow[GH], rw[GH], own[GH], rwn[GH]; pg8::u32x2 yw[SG], zw[SG], ywn[SG], zwn[SG];
    if (gw < MC) P4_LOAD(ow, rw, yw, zw, gw);
    for (int rc = gw; rc < MC; rc += NGW) {
        bf16* mr = MIX + (size_t)rc * D;
        { const int rcn = rc + NGW < MC ? rc + NGW : rc; P4_LOAD(own, rwn, ywn, zwn, rcn); }
#pragma unroll
        for (int h = 0; h < GH; ++h) {
            const f32x4 o0 = (f32x4){bf_lo(ow[h].x), bf_hi(ow[h].x), bf_lo(ow[h].y), bf_hi(ow[h].y)}, o1 = (f32x4){bf_lo(ow[h].z), bf_hi(ow[h].z), bf_lo(ow[h].w), bf_hi(ow[h].w)};
            float ss = (o0.x * o0.x + o0.y * o0.y) + (o0.z * o0.z + o0.w * o0.w) + (o1.x * o1.x + o1.y * o1.y) + (o1.z * o1.z + o1.w * o1.w);
            ss = wave_sum(ss); const float rinv = 1.f / sqrtf(ss * (1.f / DV) + EPS);
            v4u m; m.x = pk2(o0.x * rinv * w0.x * silu_f(bf_lo(rw[h].x)), o0.y * rinv * w0.y * silu_f(bf_hi(rw[h].x))); m.y = pk2(o0.z * rinv * w0.z * silu_f(bf_lo(rw[h].y)), o0.w * rinv * w0.w * silu_f(bf_hi(rw[h].y)));
            m.z = pk2(o1.x * rinv * w1.x * silu_f(bf_lo(rw[h].z)), o1.y * rinv * w1.y * silu_f(bf_hi(rw[h].z))); m.w = pk2(o1.z * rinv * w1.z * silu_f(bf_lo(rw[h].w)), o1.w * rinv * w1.w * silu_f(bf_hi(rw[h].w)));
            *(GAS v4u*)(mr + h * DV + 8 * lane) = m;
        }
#pragma unroll
        for (int g = 0; g < SG; ++g) {
            const f32x4 y = (f32x4){bf_lo(yw[g].x), bf_hi(yw[g].x), bf_lo(yw[g].y), bf_hi(yw[g].y)};
            const f32x4 yz = (f32x4){y.x * silu_f(bf_lo(zw[g].x)), y.y * silu_f(bf_hi(zw[g].x)), y.z * silu_f(bf_lo(zw[g].y)), y.w * silu_f(bf_hi(zw[g].y))};
            float ss = (yz.x * yz.x + yz.y * yz.y) + (yz.z * yz.z + yz.w * yz.w);
            ss = wave_sum(ss); const float rinv = 1.f / sqrtf(ss * (1.f / 256.f) + EPS);
            pg8::u32x2 m; m.x = pk2(yz.x * rinv * wn[g].x, yz.y * rinv * wn[g].y); m.y = pk2(yz.z * rinv * wn[g].z, yz.w * rinv * wn[g].w);
            *(GAS pg8::u32x2*)(mr + GW + g * 256 + 4 * lane) = m;
        }
#pragma unroll
        for (int h = 0; h < GH; ++h) { ow[h] = own[h]; rw[h] = rwn[h]; }
#pragma unroll
        for (int g = 0; g < SG; ++g) { yw[g] = ywn[g]; zw[g] = zwn[g]; }
    }
#undef P4_LOAD
}
#define LN_LOAD(dst, rowptr) do { const GAS pg8::u32x2* xr_ = (const GAS pg8::u32x2*)(rowptr) + lane; _Pragma("unroll") for (int j_ = 0; j_ < 16; ++j_) dst[j_] = __builtin_nontemporal_load(xr_ + 64 * j_); } while (0)
template <bool OUT_BF16> __device__ __forceinline__ void ln_row(const pg8::u32x2 (&raw)[16], const LAS float* gam, const LAS float* bet, void* orow, int lane, const LAS int* tab, const bf16* slabs, int r, int nsl, int rem) {
    f32x4 v[16]; float s = 0.f;
    const int pm = r >> 8, rl = r & 255;
#pragma unroll
    for (int j = 0; j < 16; ++j) { const pg8::u32x2 xw = raw[j]; v[j] = (f32x4){bf_lo(xw.x), bf_hi(xw.x), bf_lo(xw.y), bf_hi(xw.y)}; const int ts = tab[pm * 16 + j];
        if (ts >= 0) { pg8::u32x2 sw[7];
#pragma unroll
            for (int q = 0; q < 7; ++q) { const int qq = q < nsl ? q : 0; sw[q] = __builtin_nontemporal_load((const GAS pg8::u32x2*)(slabs + (size_t)(ts + qq * rem) * 65536 + rl * 256) + lane); }
#pragma unroll
            for (int q = 0; q < 7; ++q) { const unsigned on = q < nsl ? 0xffffffffu : 0u; const unsigned sx = sw[q].x & on, sy = sw[q].y & on; v[j] = v[j] + (f32x4){bf_lo(sx), bf_hi(sx), bf_lo(sy), bf_hi(sy)}; }
            for (int q = 7; q < nsl; ++q) { const pg8::u32x2 sx = *((const GAS pg8::u32x2*)(slabs + (size_t)(ts + q * rem) * 65536 + rl * 256) + lane); v[j] = v[j] + (f32x4){bf_lo(sx.x), bf_hi(sx.x), bf_lo(sx.y), bf_hi(sx.y)}; } }
        s += (v[j].x + v[j].y) + (v[j].z + v[j].w); }
    const float mean = wave_sum(s) * (1.f / D); float s2 = 0.f;
#pragma unroll
    for (int j = 0; j < 16; ++j) { v[j] = v[j] - mean; s2 += (v[j].x * v[j].x + v[j].y * v[j].y) + (v[j].z * v[j].z + v[j].w * v[j].w); }
    const float rstd = 1.f / sqrtf(wave_sum(s2) * (1.f / D) + EPS);
#pragma unroll
    for (int j = 0; j < 16; ++j) { const f32x4 gm = *((const LAS f32x4*)gam + lane + 64 * j), bt = *((const LAS f32x4*)bet + lane + 64 * j); const f32x4 o = v[j] * rstd * gm + bt;
        if (OUT_BF16) ((GAS unsigned long long*)orow)[lane + 64 * j] = (unsigned long long)pk2(o.x, o.y) | ((unsigned long long)pk2(o.z, o.w) << 32);
        else __builtin_nontemporal_store(o, (f32x4*)orow + lane + 64 * j); }
}

#ifndef MK_PER_PHASE
#define MK_PER_PHASE 0
#endif
constexpr int NPHASE = 10;
__global__ void __launch_bounds__(NWAVES * 64, 2) hymba_fwd(Args args) {
    extern __shared__ __attribute__((aligned(16))) unsigned char lds_raw[];
    LAS unsigned char* lds = (LAS unsigned char*)lds_raw;
    volatile LAS unsigned* MISC = (volatile LAS unsigned*)(lds + MISC_OFF);
    const int tid = threadIdx.x, wave = __builtin_amdgcn_readfirstlane(tid >> 6), G = gridDim.x;
#define lane opaque_lane(tid)
    unsigned char* ws = args.ws;
    gu32* ctl = (gu32*)(ws + WS_CTL);
    for (int u = tid; u < (LDS_BYTES - LDSCTL_OFF) / 4; u += NWAVES * 64) ((LAS unsigned*)(lds + LDSCTL_OFF))[u] = 0u;
    __syncthreads();
    XcdBarrier bar; bar.bar = (unsigned*)(ctl + CW_BAR); bar.x = 0; bar.st = nullptr;
    if (!MK_PER_PHASE) bar = xcd_barrier_post((unsigned*)(ctl + CW_BAR), MISC + 8);
    const int lo = args.ph_lo, hi = args.ph_hi;
#define IN(k) (lo <= (k) && (k) < hi)
#define SEAM(k) do { if (IN(k) && IN((k) + 1)) xcd_barrier(bar); } while (0)

    bf16* WIN = (bf16*)(ws + WS_WIN); bf16* WOUT = (bf16*)(ws + WS_WOUT); bf16* WUP = (bf16*)(ws + WS_WUP); bf16* WDN = (bf16*)(ws + WS_WDN);
    bf16* XB = (bf16*)(ws + WS_XB); bf16* Ub = (bf16*)(ws + WS_U); float* UT = (float*)(ws + WS_UT); bf16* MIX = (bf16*)(ws + WS_MIX); bf16* HB = (bf16*)(ws + WS_HB); bf16* HID = (bf16*)(ws + WS_HID);
    bf16* PRE1 = (bf16*)(ws + WS_PRE1); bf16* PRE2 = (bf16*)(ws + WS_PRE2); bf16* SLABS = (bf16*)(ws + WS_SLAB);
    const pg8::RowMap rm{args.in[0], args.in[1], args.in[5], args.out + O_YP, TP, NMETA, SEQ, MPROMPT, MTOT, D};

    if (IN(0)) { p0_prologue(args, lds, tid, lane, wave, G); } SEAM(0);
    if (IN(1)) { const int nu1 = (MP / 256) * (NIN_PAD / 256), rounds1 = (nu1 + G - 1) / G, G1 = (nu1 + rounds1 - 1) / rounds1;
        if ((int)blockIdx.x < G1) { pg8::Gemm g{XB, WIN, MP, NIN_PAD, D}; pg8::StaticOrder S; S.init(MP, NIN_PAD, G1, (int)blockIdx.x);
            pg8::EpiInProj E{Ub, UT, NU, NU / 256};
            pg8::gemm_phase<pg8::EpiInProj, pg8::StaticOrder, true, true>(lds + RING_OFF, g, S, E); }
        convert_queue(args, lds, lane, wave, ctl + CW_CV0, 0); } SEAM(1);
    if (IN(2)) { p2_prepass(args, lds, tid, G, ctl, MISC); } SEAM(2);
    if (IN(3)) { p3_mixers(args, lds, tid, lane, wave, G, ctl, MISC, CW_Q);
    } SEAM(3);
    if (IN(4)) { p4_finalize(args, lane, wave, G); } SEAM(4);
    if (IN(5)) { pg8::Gemm g{MIX, WOUT, MC, D, D}; pg8::HybridOrder S; S.init(MC, D, D, G, (int)blockIdx.x);
        pg8::EpiResX E{rm, XB, PRE1, D, ALPHA, SLABS + (size_t)(S.rem ? S.slab_of((int)blockIdx.x / S.rem, (int)blockIdx.x % S.rem) : 0) * 65536};
        pg8::gemm_phase<pg8::EpiResX, pg8::HybridOrder, true, true>(lds + RING_OFF, g, S, E); } SEAM(5);
    if (IN(6)) { const int gw = wave * G + blockIdx.x, NGW = G * NWAVES;
        LAS int* tab = (LAS int*)(lds + RING_OFF); pg8::HybridOrder HS; HS.init(MC, D, D, G, 0);
        for (int i = tid; i < (MC / 256) * 16; i += NWAVES * 64) tab[i] = -1;
        LAS float* lgam = (LAS float*)(lds + RING_OFF + 4096); LAS float* lbet = lgam + D;
        for (int i = tid; i < D / 4; i += NWAVES * 64) { ((LAS f32x4*)lgam)[i] = ((const f32x4*)args.in[17])[i]; ((LAS f32x4*)lbet)[i] = ((const f32x4*)args.in[18])[i]; }
        __syncthreads(); for (int i = tid; i < HS.rem; i += NWAVES * 64) { pg8::Unit tu; HS.tail_unit(i, tu); tab[tu.pm * 16 + tu.pn] = i; } __syncthreads();
        if (gw < MC) { pg8::u32x2 raw[16], nraw[16]; LN_LOAD(raw, PRE1 + (size_t)gw * D);
            for (int r = gw; r < MC; r += NGW) { const int rn = r + NGW < MC ? r + NGW : r; LN_LOAD(nraw, PRE1 + (size_t)rn * D);
                ln_row<true>(raw, lgam, lbet, HB + (size_t)r * D, lane, tab, SLABS, r, HS.sp - 1, HS.rem);
#pragma unroll
                for (int j = 0; j < 16; ++j) raw[j] = nraw[j]; } } } SEAM(6);
    if (IN(7)) { const int nu7 = (MC / 256) * (DFF / 256), rounds7 = (nu7 + G - 1) / G, G7 = (nu7 + rounds7 - 1) / rounds7;
        if ((int)blockIdx.x < G7) { pg8::Gemm g{HB, WUP, MC, DFF, D}; pg8::StaticOrder S; S.init(MC, DFF, G7, (int)blockIdx.x);
            pg8::EpiRelu2 E{HID, DFF};
            pg8::gemm_phase<pg8::EpiRelu2, pg8::StaticOrder, true, true>(lds + RING_OFF, g, S, E); }
        if ((int)blockIdx.x < G7 || wave < 5) convert_queue(args, lds, lane, wave, ctl + CW_CV1, 1); } SEAM(7);
    if (IN(8)) { pg8::Gemm g{HID, WDN, MC, D, DFF}; pg8::HybridOrder S; S.init(MC, D, DFF, G, (int)blockIdx.x);
        pg8::EpiResH E{PRE2, HB, D, ALPHA, SLABS + (size_t)(S.rem ? S.slab_of((int)blockIdx.x / S.rem, (int)blockIdx.x % S.rem) : 0) * 65536};
        pg8::gemm_phase<pg8::EpiResH, pg8::HybridOrder, true, true>(lds + RING_OFF, g, S, E); } SEAM(8);
    if (IN(9)) { const int gw = wave * G + blockIdx.x, NGW = G * NWAVES;
        LAS int* tab = (LAS int*)(lds + RING_OFF); pg8::HybridOrder HS; HS.init(MC, D, DFF, G, 0);
        for (int i = tid; i < (MC / 256) * 16; i += NWAVES * 64) tab[i] = -1;
        LAS float* lgam = (LAS float*)(lds + RING_OFF + 4096); LAS float* lbet = lgam + D;
        for (int i = tid; i < D / 4; i += NWAVES * 64) { ((LAS f32x4*)lgam)[i] = ((const f32x4*)args.in[21])[i]; ((LAS f32x4*)lbet)[i] = ((const f32x4*)args.in[22])[i]; }
        __syncthreads(); for (int i = tid; i < HS.rem; i += NWAVES * 64) { pg8::Unit tu; HS.tail_unit(i, tu); tab[tu.pm * 16 + tu.pn] = i; } __syncthreads();
        if (gw < MC) { pg8::u32x2 raw[16], nraw[16]; LN_LOAD(raw, PRE2 + (size_t)gw * D);
            for (int r = gw; r < MC; r += NGW) { const int rn = r + NGW < MC ? r + NGW : r; LN_LOAD(nraw, PRE2 + (size_t)rn * D);
                ln_row<false>(raw, lgam, lbet, args.out + O_YP + (size_t)r * D, lane, tab, SLABS, r, HS.sp - 1, HS.rem);
#pragma unroll
                for (int j = 0; j < 16; ++j) raw[j] = nraw[j]; } } }
#undef IN
#undef SEAM
#undef lane
}

extern "C" void kernel_launch(void* const* d_in, const int* in_sizes, int n_in, void* d_out, int out_size, void* d_ws, size_t ws_size, hipStream_t stream) {
    static int grid = 0;
    if (grid == 0) {
        if (n_in != 23 || (size_t)out_size != O_END || ws_size < WS_END) { fprintf(stderr, "kernel_launch: shape mismatch: n_in %d out %d ws %zu (need 23, %zu, %zu)\n", n_in, out_size, ws_size, (size_t)O_END, (size_t)WS_END); grid = -1; return; }
        int dev = 0, cus = 0, per_cu = 0;
        if (hipGetDevice(&dev) != hipSuccess || hipDeviceGetAttribute(&cus, hipDeviceAttributeMultiprocessorCount, dev) != hipSuccess) { grid = -1; return; }
        if (hipFuncSetAttribute((const void*)hymba_fwd, hipFuncAttributeMaxDynamicSharedMemorySize, LDS_BYTES) != hipSuccess) { fprintf(stderr, "kernel_launch: hipFuncSetAttribute failed\n"); grid = -1; return; }
        if (hipOccupancyMaxActiveBlocksPerMultiprocessor(&per_cu, (const void*)hymba_fwd, NWAVES * 64, LDS_BYTES) != hipSuccess || per_cu < 1) { fprintf(stderr, "kernel_launch: occupancy query reports %d blocks per CU\n", per_cu); }
        (void)hipGetLastError();
        grid = cus;
    }
    if (grid < 0) return;
    (void)hipMemsetAsync((char*)d_ws + WS_CTL, 0, CTL_ZERO_BYTES, stream);
    Args a{};
    for (int i = 0; i < 23; ++i) a.in[i] = (const float*)d_in[i];
    a.out = (float*)d_out; a.ws = (unsigned char*)d_ws;
#if MK_PER_PHASE
    for (int p = 0; p < NPHASE; ++p) { a.ph_lo = p; a.ph_hi = p + 1; hipLaunchKernelGGL(hymba_fwd, dim3(grid), dim3(NWAVES * 64), LDS_BYTES, stream, a); }
#else
    a.ph_lo = 0; a.ph_hi = NPHASE;
    hipLaunchKernelGGL(hymba_fwd, dim3(grid), dim3(NWAVES * 64), LDS_BYTES, stream, a);
#endif
    const hipError_t le = hipPeekAtLastError();
    if (le != hipSuccess) fprintf(stderr, "kernel_launch: launch failed: %s\n", hipGetErrorName(le));
}
```

```cpp
#include <hip/hip_runtime.h>
#include <cstdio>
#include <cstdint>
namespace pg8 {
#define PG8_LAS __attribute__((address_space(3)))
typedef unsigned short bf16_t;
typedef short bf16x8 __attribute__((ext_vector_type(8)));
typedef float f32x4 __attribute__((ext_vector_type(4)));
typedef unsigned u32x4 __attribute__((ext_vector_type(4)));
constexpr int BM = 256, BK = 64, HALF = 128, HTB = HALF * BK * 2  , STAGE_BYTES = 8 * HTB, NXCD = 8, WGM = 8;

__host__ __device__ __forceinline__ int lds_byte(int r, int c) { const int st = (r >> 4) * 2 + (c >> 5), rr = r & 15, cc = c & 31, ob = rr * 64 + cc * 2; return st * 1024 + (ob ^ (((ob >> 9) & 1) << 5)); }
__host__ __device__ __forceinline__ void stage_rc(int b, int& R, int& C) { const int st = b / 1024, sb = b % 1024, swz = sb ^ (((sb >> 9) & 1) << 5); R = (st >> 1) * 16 + swz / 64; C = (st & 1) * 32 + (swz % 64) / 2; }
__host__ __device__ __forceinline__ int perm32(int rho) { const int n = rho >> 4, i = rho & 15; return 8 * (i >> 2) + 4 * n + (i & 3); }

struct Unit { int pm, pn, kt0, nkt; };
struct Gemm { const bf16_t* A; const bf16_t* Bt; int M, N, K; };

struct StaticOrder {
    static constexpr bool SPLITK = false;
    int nM, nN, nwg, G, c;
    __host__ __device__ void init(int M, int N, int G_, int c_) { nM = M / BM; nN = N / BM; nwg = nM * nN; G = G_; c = c_; }
    __host__ __device__ bool next(int i, Unit& u) const {
        const long L = (long)i * G + c; if (L >= nwg) return false;
        int wgid = (int)L; { const int q = nwg / NXCD, r = nwg % NXCD, xcd = wgid % NXCD, off = wgid / NXCD; wgid = (xcd < r ? xcd * (q + 1) : r * (q + 1) + (xcd - r) * q) + off; }
        const int nig = WGM * nN, gid = wgid / nig, fm = gid * WGM, gsz = (nM - fm) < WGM ? (nM - fm) : WGM;
        u.pm = fm + ((wgid % nig) % gsz); u.pn = (wgid % nig) / gsz; return true;
    }
    __device__ __forceinline__ void a_ready(const Unit&) const {}
    __device__ __forceinline__ void done(const Unit&) const {}
};

struct HybridOrder : StaticOrder {
    static constexpr bool SPLITK = true;
    int KT, nfull, rem, sp;
    __host__ __device__ void init(int M, int N, int K, int G_, int c_) { StaticOrder::init(M, N, G_, c_); KT = K / BK; nfull = nwg / G; rem = nwg - nfull * G; sp = rem ? G / rem : 1; if (sp > KT / 2) sp = KT / 2; }
    __host__ __device__ bool next(int i, Unit& u) const {
        if (i < nfull) { const bool ok = StaticOrder::next(i, u); u.kt0 = 0; u.nkt = KT; return ok; }
        if (i > nfull || c >= rem * sp) return false;
        const int cp = c % rem, s = c / rem; StaticOrder t = *this; t.c = cp; t.next(nfull, u);
        const int hp = KT / 2, p0 = (s * hp) / sp, p1 = ((s + 1) * hp) / sp; u.kt0 = 2 * p0; u.nkt = 2 * (p1 - p0); return true;
    }
    __host__ __device__ void tail_unit(int cp, Unit& u) const { StaticOrder t = *this; t.c = cp; t.next(nfull, u); }
    __host__ __device__ int slab_of(int s, int cp) const { return (s - 1) * rem + cp; }
    __device__ __forceinline__ void a_ready(const Unit&) const {}
    __device__ __forceinline__ void done(const Unit&) const {}
};
__device__ __forceinline__ unsigned cvt_pk_bf16(float lo, float hi) { unsigned r; asm volatile("v_cvt_pk_bf16_f32 %0, %1, %2" : "=v"(r) : "v"(lo), "v"(hi)); return r; }
typedef unsigned u32x2 __attribute__((ext_vector_type(2)));

struct EpiInProj {
    static constexpr bool PERM = true, AFTER_DRAIN = false;
    bf16_t* U; float* UT; int ldu; int ntile_main;
    __device__ __forceinline__ void operator()(const f32x4 (&acc)[2][2][4][2], const Unit& u, int wr, int wc, int fr, int fq) const {
        const int row0 = u.pm * BM + wr * 64 + fr;
        if (u.pn < ntile_main) {
            const int col0 = u.pn * BM + wc * 32 + 8 * fq;
#pragma unroll
            for (int ai = 0; ai < 2; ++ai)
#pragma unroll
                for (int m = 0; m < 4; ++m) { bf16_t* rowp = U + (size_t)(row0 + ai * HALF + m * 16) * ldu + col0;
#pragma unroll
                    for (int bj = 0; bj < 2; ++bj) { const f32x4 v0 = acc[ai][bj][m][0], v1 = acc[ai][bj][m][1];
                        u32x4 w; w.x = cvt_pk_bf16(v0[0], v0[1]); w.y = cvt_pk_bf16(v0[2], v0[3]); w.z = cvt_pk_bf16(v1[0], v1[1]); w.w = cvt_pk_bf16(v1[2], v1[3]);
                        *(u32x4*)(rowp + bj * HALF) = w; } }
        } else if (wc < 2) {
            const int tc = wc * 32 + 8 * fq;
#pragma unroll
            for (int ai = 0; ai < 2; ++ai)
#pragma unroll
                for (int m = 0; m < 4; ++m) { float* rowp = UT + (size_t)(row0 + ai * HALF + m * 16) * 64 + tc;
                    *(f32x4*)(rowp) = acc[ai][0][m][0]; *(f32x4*)(rowp + 4) = acc[ai][0][m][1]; }
        }
    }
};
struct EpiRelu2 {
    static constexpr bool PERM = true, AFTER_DRAIN = false;
    bf16_t* O; int ldc;
    __device__ __forceinline__ void operator()(const f32x4 (&acc)[2][2][4][2], const Unit& u, int wr, int wc, int fr, int fq) const {
        const int row0 = u.pm * BM + wr * 64 + fr, col0 = u.pn * BM + wc * 32 + 8 * fq;
#pragma unroll
        for (int ai = 0; ai < 2; ++ai)
#pragma unroll
            for (int m = 0; m < 4; ++m) { bf16_t* rowp = O + (size_t)(row0 + ai * HALF + m * 16) * ldc + col0;
#pragma unroll
                for (int bj = 0; bj < 2; ++bj) { f32x4 v0 = acc[ai][bj][m][0], v1 = acc[ai][bj][m][1];
#pragma unroll
                    for (int j = 0; j < 4; ++j) { const float a = fmaxf(v0[j], 0.f), b = fmaxf(v1[j], 0.f); v0[j] = a * a; v1[j] = b * b; }
                    u32x4 w; w.x = cvt_pk_bf16(v0[0], v0[1]); w.y = cvt_pk_bf16(v0[2], v0[3]); w.z = cvt_pk_bf16(v1[0], v1[1]); w.w = cvt_pk_bf16(v1[2], v1[3]);
                    *(u32x4*)(rowp + bj * HALF) = w; } }
    }
};
struct RowMap {
    const float* xp; const float* xs; const float* meta; float* y; int tp, nmeta, seq, mprompt, mtot, d;
    __device__ __forceinline__ const float* src(int r) const {
        if (r < mprompt) { const int b = r / tp, t = r - b * tp; return t < nmeta ? meta + (size_t)t * d : xp + (size_t)(b * seq + t - nmeta) * d; }
        return xs + (size_t)(r - mprompt) * d;
    }
    __device__ __forceinline__ const float* csrc(int rc) const { const int np = (mprompt / tp) * seq; return rc < np ? xp + (size_t)rc * d : xs + (size_t)(rc - np) * d; }
    __device__ __forceinline__ int xbrow(int rc) const { const int np = (mprompt / tp) * seq; return rc < np ? (rc / seq) * tp + nmeta + (rc % seq) : rc - np + mprompt; }
    __device__ __forceinline__ float* dst(int r) const {
        if (r < mprompt) { const int b = r / tp, t = r - b * tp; return t < nmeta ? nullptr : y + (size_t)(b * seq + t - nmeta) * d; }
        return r < mtot ? y + (size_t)(r - mprompt + (mprompt / tp) * seq) * d : nullptr;
    }
};
__device__ __forceinline__ void store_slab_perm(bf16_t* slab, const f32x4 (&acc)[2][2][4][2], int wr, int wc, int fr, int fq) {
#pragma unroll
    for (int ai = 0; ai < 2; ++ai)
#pragma unroll
        for (int m = 0; m < 4; ++m) { bf16_t* o = slab + (size_t)(ai * HALF + wr * 64 + m * 16 + fr) * BM + wc * 32 + 8 * fq;
#pragma unroll
            for (int bj = 0; bj < 2; ++bj) { const f32x4 v0 = acc[ai][bj][m][0], v1 = acc[ai][bj][m][1];
                u32x4 w; w.x = cvt_pk_bf16(v0[0], v0[1]); w.y = cvt_pk_bf16(v0[2], v0[3]); w.z = cvt_pk_bf16(v1[0], v1[1]); w.w = cvt_pk_bf16(v1[2], v1[3]);
                *(u32x4*)(o + bj * HALF) = w; } }
}
struct EpiResX {
    static constexpr bool PERM = true, AFTER_DRAIN = false;
    RowMap rm; const bf16_t* xb; bf16_t* out; int ldc; float alpha; bf16_t* slab;
    __device__ __forceinline__ void operator()(const f32x4 (&acc)[2][2][4][2], const Unit& u, int wr, int wc, int fr, int fq) const {
        if (u.kt0 != 0) { store_slab_perm(slab, acc, wr, wc, fr, fq); return; }
        const int row0 = u.pm * BM + wr * 64 + fr, col0 = u.pn * BM + wc * 32 + 8 * fq;
        u32x4 xr[2][4][2];
#pragma unroll
        for (int ai = 0; ai < 2; ++ai)
#pragma unroll
            for (int m = 0; m < 4; ++m) { const bf16_t* s = xb + (size_t)rm.xbrow(row0 + ai * HALF + m * 16) * ldc + col0;
#pragma unroll
                for (int bj = 0; bj < 2; ++bj) xr[ai][m][bj] = *(const u32x4*)(s + bj * HALF); }
#pragma unroll
        for (int ai = 0; ai < 2; ++ai)
#pragma unroll
            for (int m = 0; m < 4; ++m) { bf16_t* o = out + (size_t)(row0 + ai * HALF + m * 16) * ldc + col0;
#pragma unroll
                for (int bj = 0; bj < 2; ++bj) { const u32x4 hv = xr[ai][m][bj];
                    f32x4 x0, x1; x0[0] = __uint_as_float(hv.x << 16); x0[1] = __uint_as_float(hv.x & 0xffff0000u); x0[2] = __uint_as_float(hv.y << 16); x0[3] = __uint_as_float(hv.y & 0xffff0000u);
                    x1[0] = __uint_as_float(hv.z << 16); x1[1] = __uint_as_float(hv.z & 0xffff0000u); x1[2] = __uint_as_float(hv.w << 16); x1[3] = __uint_as_float(hv.w & 0xffff0000u);
                    const f32x4 v0 = x0 * alpha + acc[ai][bj][m][0], v1 = x1 * alpha + acc[ai][bj][m][1];
                    u32x4 w; w.x = cvt_pk_bf16(v0[0], v0[1]); w.y = cvt_pk_bf16(v0[2], v0[3]); w.z = cvt_pk_bf16(v1[0], v1[1]); w.w = cvt_pk_bf16(v1[2], v1[3]);
                    *(u32x4*)(o + bj * HALF) = w; } }
    }
};
struct EpiResH {
    static constexpr bool PERM = true, AFTER_DRAIN = false;
    bf16_t* out; const bf16_t* hb; int ldc; float alpha; bf16_t* slab;
    __device__ __forceinline__ void operator()(const f32x4 (&acc)[2][2][4][2], const Unit& u, int wr, int wc, int fr, int fq) const {
        if (u.kt0 != 0) { store_slab_perm(slab, acc, wr, wc, fr, fq); return; }
        const int row0 = u.pm * BM + wr * 64 + fr, col0 = u.pn * BM + wc * 32 + 8 * fq;
        u32x4 xr[2][4][2];
#pragma unroll
        for (int ai = 0; ai < 2; ++ai)
#pragma unroll
            for (int m = 0; m < 4; ++m) { const bf16_t* s = hb + (size_t)(row0 + ai * HALF + m * 16) * ldc + col0;
#pragma unroll
                for (int bj = 0; bj < 2; ++bj) xr[ai][m][bj] = *(const u32x4*)(s + bj * HALF); }
#pragma unroll
        for (int ai = 0; ai < 2; ++ai)
#pragma unroll
            for (int m = 0; m < 4; ++m) { bf16_t* o = out + (size_t)(row0 + ai * HALF + m * 16) * ldc + col0;
#pragma unroll
                for (int bj = 0; bj < 2; ++bj) { const u32x4 hv = xr[ai][m][bj];
                    f32x4 x0, x1; x0[0] = __uint_as_float(hv.x << 16); x0[1] = __uint_as_float(hv.x & 0xffff0000u); x0[2] = __uint_as_float(hv.y << 16); x0[3] = __uint_as_float(hv.y & 0xffff0000u);
                    x1[0] = __uint_as_float(hv.z << 16); x1[1] = __uint_as_float(hv.z & 0xffff0000u); x1[2] = __uint_as_float(hv.w << 16); x1[3] = __uint_as_float(hv.w & 0xffff0000u);
                    const f32x4 v0 = x0 * alpha + acc[ai][bj][m][0], v1 = x1 * alpha + acc[ai][bj][m][1];
                    u32x4 w; w.x = cvt_pk_bf16(v0[0], v0[1]); w.y = cvt_pk_bf16(v0[2], v0[3]); w.z = cvt_pk_bf16(v1[0], v1[1]); w.w = cvt_pk_bf16(v1[2], v1[3]);
                    *(u32x4*)(o + bj * HALF) = w; } }
    }
};

#ifndef KLOOP_OFF_V
#define KLOOP_OFF_V 44
#endif
constexpr int KLOOP_OFF = KLOOP_OFF_V;
template <class Epi, class Sched, bool ALIGN_EPI = false, bool SP2 = false>
__device__ __forceinline__ void gemm_phase(PG8_LAS unsigned char* lds, const Gemm g, const Sched& S, const Epi& E) {
    const int tid = threadIdx.x, wid = __builtin_amdgcn_readfirstlane(tid >> 6), lane = tid & 63, wr = wid >> 2, wc = wid & 3, fr = lane & 15, fq = lane >> 4;
    const int K = g.K, nt = K / BK;
    unsigned voffA[2], voffB[2];
#pragma unroll
    for (int i = 0; i < 2; ++i) { int R, C; stage_rc(tid * 16 + i * 8192, R, C); const int Rb = Epi::PERM ? ((R & ~31) + perm32(R & 31)) : R;
        voffA[i] = (unsigned)(R * K + C) * 2u; voffB[i] = (unsigned)(Rb * K + C) * 2u; }
    const size_t kstep = (size_t)(BK * 2);
    const size_t hstep = (size_t)HALF * K * 2;
    const size_t tstep = 2 * hstep;
    const unsigned ldsw = (unsigned)wid * 1024u;
    const int aoff = lds_byte(wr * 64 + fr, fq * 8), boff = lds_byte(wc * 32 + fr, fq * 8);
#define PG8_SA(b, h) (((b) * 2 + (h)) * HTB)
#define PG8_SB(b, h) ((4 + (b) * 2 + (h)) * HTB)
#define PG8_STAGE(bufoff, gbase, voff) do { _Pragma("unroll") for (int _i = 0; _i < 2; ++_i) \
        __builtin_amdgcn_global_load_lds((const unsigned*)((const char*)(gbase) + (voff)[_i]), (PG8_LAS unsigned*)(lds + (bufoff) + ldsw + _i * 8192), 16, 0, 0); } while (0)
#define PG8_LDA(dst, b, h) do { _Pragma("unroll") for (int m = 0; m < 4; ++m) _Pragma("unroll") for (int k = 0; k < 2; ++k) dst[m][k] = *(const PG8_LAS bf16x8*)(lds + PG8_SA(b, h) + aoff + m * 2048 + k * 1024); } while (0)
#define PG8_LDB(dst, b, h) do { _Pragma("unroll") for (int n = 0; n < 2; ++n) _Pragma("unroll") for (int k = 0; k < 2; ++k) dst[n][k] = *(const PG8_LAS bf16x8*)(lds + PG8_SB(b, h) + boff + n * 2048 + k * 1024); } while (0)
#define PG8_MMA(ai, bj, At, Bt) do { __builtin_amdgcn_s_setprio(1); _Pragma("unroll") for (int m = 0; m < 4; ++m) _Pragma("unroll") for (int n = 0; n < 2; ++n) _Pragma("unroll") for (int k = 0; k < 2; ++k) \
        acc[ai][bj][m][n] = __builtin_amdgcn_mfma_f32_16x16x32_bf16(Bt[n][k], At[m][k], acc[ai][bj][m][n], 0, 0, 0); __builtin_amdgcn_s_setprio(0); } while (0)
#define PG8_WAIT_V(n) asm volatile("s_waitcnt vmcnt(" #n ")" ::: "memory")
#define PG8_WAIT_L(n) asm volatile("s_waitcnt lgkmcnt(" #n ")" ::: "memory")
#define PG8_BAR __builtin_amdgcn_s_barrier()
#define PG8_SCHED __builtin_amdgcn_sched_barrier(0)
    Unit cur, nxt; int ui = 0;
    if (!S.next(0, cur)) return;
    if constexpr (!Sched::SPLITK) { cur.kt0 = 0; cur.nkt = nt; }
    f32x4 acc[2][2][4][2];
#pragma unroll
    for (int a = 0; a < 2; ++a)
#pragma unroll
        for (int b = 0; b < 2; ++b)
#pragma unroll
            for (int m = 0; m < 4; ++m)
#pragma unroll
                for (int n = 0; n < 2; ++n) acc[a][b][m][n] = (f32x4){0.f, 0.f, 0.f, 0.f};
    bf16x8 At[4][2], B0[2][2], B1[2][2];
    const char* cA = (const char*)g.A + (size_t)cur.pm * tstep + (size_t)cur.kt0 * kstep; const char* cB = (const char*)g.Bt + (size_t)cur.pn * tstep + (size_t)cur.kt0 * kstep;
    S.a_ready(cur);
    if constexpr (SP2) {
        PG8_STAGE(PG8_SB(0, 0), cB, voffB); PG8_STAGE(PG8_SB(0, 1), cB + hstep, voffB); PG8_STAGE(PG8_SA(0, 0), cA, voffA); PG8_STAGE(PG8_SA(0, 1), cA + hstep, voffA);
        if (wr == 1) PG8_BAR;
        PG8_WAIT_V(2); PG8_BAR;
        PG8_STAGE(PG8_SB(1, 0), cB + kstep, voffB); PG8_STAGE(PG8_SA(1, 0), cA + kstep, voffA); PG8_STAGE(PG8_SB(1, 1), cB + hstep + kstep, voffB);
        PG8_WAIT_V(6); PG8_BAR;
    } else {
        PG8_STAGE(PG8_SB(0, 0), cB, voffB); PG8_STAGE(PG8_SA(0, 0), cA, voffA); PG8_STAGE(PG8_SB(0, 1), cB + hstep, voffB); PG8_STAGE(PG8_SA(0, 1), cA + hstep, voffA);
        if (wr == 1) PG8_BAR;
        PG8_WAIT_V(4); PG8_BAR;
        PG8_STAGE(PG8_SB(1, 0), cB + kstep, voffB); PG8_STAGE(PG8_SA(1, 0), cA + kstep, voffA); PG8_STAGE(PG8_SB(1, 1), cB + hstep + kstep, voffB);
        PG8_WAIT_V(6); PG8_BAR;
    }
    for (;;) {
        const bool has_next = S.next(ui + 1, nxt);
        if constexpr (!Sched::SPLITK) { nxt.kt0 = 0; nxt.nkt = nt; }
        const int cnt = cur.nkt;
        const char* nA = has_next ? (const char*)g.A + (size_t)nxt.pm * tstep + (size_t)nxt.kt0 * kstep : cA; const char* nB = has_next ? (const char*)g.Bt + (size_t)nxt.pn * tstep + (size_t)nxt.kt0 * kstep : cB;
        { constexpr int pre = Sched::SPLITK ? 0 : 20, nops = ((KLOOP_OFF - pre + 64) % 64) / 4;
          asm volatile(".p2align 6\n\t.rept %0\n\ts_nop 0\n\t.endr" :: "i"(nops) : "memory"); }
        for (int t = 0; t < cnt; t += 2) {
            const bool last = (t == cnt - 2);
            const char* a1 = cA + (size_t)(t + 1) * kstep;
            const char* a2 = last ? nA : cA + (size_t)(t + 2) * kstep; const char* b2 = last ? nB : cB + (size_t)(t + 2) * kstep;
            const char* a3 = a2 + kstep; const char* b3 = b2 + kstep;
            if (last && has_next) S.a_ready(nxt);
            if constexpr (SP2) {
            PG8_LDB(B0, 0, 0); PG8_LDB(B1, 0, 1); PG8_SCHED; PG8_LDA(At, 0, 0); PG8_STAGE(PG8_SA(1, 1), a1 + hstep, voffA);
            PG8_WAIT_V(8); PG8_WAIT_L(0); PG8_BAR; PG8_MMA(0, 0, At, B0); PG8_MMA(0, 1, At, B1); PG8_BAR; PG8_SCHED;
            PG8_LDA(At, 0, 1); PG8_STAGE(PG8_SB(0, 0), b2, voffB); PG8_STAGE(PG8_SB(0, 1), b2 + hstep, voffB); PG8_STAGE(PG8_SA(0, 0), a2, voffA);
            PG8_WAIT_V(8); PG8_WAIT_L(0); PG8_BAR; PG8_MMA(1, 0, At, B0); PG8_MMA(1, 1, At, B1); PG8_BAR; PG8_SCHED;
            PG8_LDB(B0, 1, 0); PG8_LDB(B1, 1, 1); PG8_SCHED; PG8_LDA(At, 1, 0); PG8_STAGE(PG8_SA(0, 1), a2 + hstep, voffA);
            PG8_WAIT_V(8); PG8_WAIT_L(0); PG8_BAR; PG8_MMA(0, 0, At, B0); PG8_MMA(0, 1, At, B1); PG8_BAR; PG8_SCHED;
            PG8_LDA(At, 1, 1); PG8_STAGE(PG8_SB(1, 0), b3, voffB); PG8_STAGE(PG8_SB(1, 1), b3 + hstep, voffB); PG8_STAGE(PG8_SA(1, 0), a3, voffA);
            PG8_WAIT_V(8); PG8_WAIT_L(0); PG8_BAR; PG8_MMA(1, 0, At, B0); PG8_MMA(1, 1, At, B1); PG8_BAR; PG8_SCHED;
            } else {
            PG8_LDB(B0, 0, 0); PG8_SCHED; PG8_LDA(At, 0, 0); PG8_STAGE(PG8_SA(1, 1), a1 + hstep, voffA);
            PG8_WAIT_L(8); PG8_BAR; PG8_WAIT_L(0); PG8_MMA(0, 0, At, B0); PG8_BAR; PG8_SCHED;
            PG8_LDB(B1, 0, 1); PG8_STAGE(PG8_SB(0, 0), b2, voffB);
            PG8_BAR; PG8_WAIT_L(0); PG8_MMA(0, 1, At, B1); PG8_BAR;
            PG8_LDA(At, 0, 1); PG8_STAGE(PG8_SA(0, 0), a2, voffA);
            PG8_BAR; PG8_WAIT_L(0); PG8_MMA(1, 0, At, B0); PG8_BAR; PG8_SCHED;
            PG8_STAGE(PG8_SB(0, 1), b2 + hstep, voffB);
            PG8_WAIT_V(6); PG8_BAR; PG8_MMA(1, 1, At, B1); PG8_BAR;
            PG8_LDB(B0, 1, 0); PG8_SCHED; PG8_LDA(At, 1, 0); PG8_STAGE(PG8_SA(0, 1), a2 + hstep, voffA);
            PG8_WAIT_L(8); PG8_BAR; PG8_WAIT_L(0); PG8_MMA(0, 0, At, B0); PG8_BAR; PG8_SCHED;
            PG8_LDB(B1, 1, 1); PG8_STAGE(PG8_SB(1, 0), b3, voffB);
            PG8_BAR; PG8_WAIT_L(0); PG8_MMA(0, 1, At, B1); PG8_BAR;
            PG8_LDA(At, 1, 1); PG8_STAGE(PG8_SA(1, 0), a3, voffA);
            PG8_BAR; PG8_WAIT_L(0); PG8_MMA(1, 0, At, B0); PG8_BAR; PG8_SCHED;
            PG8_STAGE(PG8_SB(1, 1), b3 + hstep, voffB);
            PG8_WAIT_V(6); PG8_BAR; PG8_MMA(1, 1, At, B1); PG8_BAR;
            }
        }
        if constexpr (ALIGN_EPI) { if (wr == 0) PG8_BAR; }
        if constexpr (!Epi::AFTER_DRAIN) { E(acc, cur, wr, wc, fr, fq); S.done(cur); }
        if (!has_next) break;
#pragma unroll
        for (int a = 0; a < 2; ++a)
#pragma unroll
            for (int b = 0; b < 2; ++b)
#pragma unroll
                for (int m = 0; m < 4; ++m)
#pragma unroll
                    for (int n = 0; n < 2; ++n) acc[a][b][m][n] = (f32x4){0.f, 0.f, 0.f, 0.f};
        cur = nxt; cA = nA; cB = nB; ++ui;
        if constexpr (ALIGN_EPI) { if (wr == 1) PG8_BAR; }
    }
    PG8_WAIT_V(0);
    if constexpr (!ALIGN_EPI) { if (wr == 0) PG8_BAR; }
    PG8_BAR;
    if constexpr (Epi::AFTER_DRAIN) { E.fused(acc, cur, wr, wc, fr, fq, lds, wid, lane); S.done(cur); }
#undef PG8_SA
#undef PG8_SB
#undef PG8_STAGE
#undef PG8_LDA
#undef PG8_LDB
#undef PG8_MMA
#undef PG8_WAIT_V
#undef PG8_WAIT_L
#undef PG8_BAR
#undef PG8_SCHED
}
}
#define GAS __attribute__((address_space(1)))
#define LAS __attribute__((address_space(3)))
typedef unsigned short bf16;
typedef unsigned v4u __attribute__((ext_vector_type(4)));
typedef float f32x4 __attribute__((ext_vector_type(4)));
typedef short bf16x8 __attribute__((ext_vector_type(8)));
typedef GAS unsigned gu32;
typedef GAS unsigned long long gu64;
#define RLX_AGENT __ATOMIC_RELAXED, __HIP_MEMORY_SCOPE_AGENT
#define LDS_WAIT() asm volatile("s_waitcnt lgkmcnt(0)" ::: "memory")
#define VM_WAIT() asm volatile("s_waitcnt vmcnt(0)" ::: "memory")
__device__ __forceinline__ unsigned long long rt() { return __builtin_amdgcn_s_memrealtime(); }
__device__ __forceinline__ unsigned f2bf(float f) { unsigned u = __builtin_bit_cast(unsigned, f); return (u + 0x7fffu + ((u >> 16) & 1u)) >> 16; }
__device__ __forceinline__ unsigned pk2_sw(float lo, float hi) { return f2bf(lo) | (f2bf(hi) << 16); }
__device__ __forceinline__ unsigned pk2(float lo, float hi) { unsigned r; asm("v_cvt_pk_bf16_f32 %0, %1, %2" : "=v"(r) : "v"(lo), "v"(hi)); return r; }

#define XB_TMO      128
#define XB_XCNT(j)  (256  + 64 * (j))
#define XB_XSUB(j)  (1280 + 64 * (j))
#define XB_XGEN(j)  (2304 + 64 * (j))
#define XB_TOP      3328
#define XB_TOPGEN   3392
#define XCD_BAR_WORDS 3456
#define XB_SPIN_CAP (1u << 22)

__device__ __forceinline__ unsigned xb_ld(unsigned* p)              { return __hip_atomic_load(p, __ATOMIC_RELAXED, __HIP_MEMORY_SCOPE_AGENT); }
__device__ __forceinline__ unsigned xb_add(unsigned* p, unsigned v) { return __hip_atomic_fetch_add(p, v, __ATOMIC_RELAXED, __HIP_MEMORY_SCOPE_AGENT); }
__device__ __forceinline__ unsigned xb_xcc_id() { return (unsigned)__builtin_amdgcn_s_getreg((3 << 11) | 20) & 0xFu; }
#define XB_SPIN(cond, bar) do { unsigned _sp = 0; while (cond) { __builtin_amdgcn_s_sleep(1); \
    if ((++_sp & 255u) == 0u) { if (xb_ld(&(bar)[XB_TMO])) break; if (_sp > XB_SPIN_CAP) { atomicAdd(&(bar)[XB_TMO], 1u); break; } } } } while (0)

struct XcdBarrier {
    unsigned* bar; unsigned x;
    volatile LAS unsigned* st;
};

__device__ __forceinline__ XcdBarrier xcd_barrier_post(unsigned* bar, volatile LAS unsigned* st) {
    XcdBarrier b; b.bar = bar; b.x = xb_xcc_id(); b.st = st;
    if (threadIdx.x == 0) (void)xb_add(&bar[XB_XCNT(b.x)], 1u);
    return b;
}
__device__ __forceinline__ void xcd_barrier_complete(unsigned* bar, unsigned x, unsigned& nloc, unsigned& nx) {
    const unsigned G = gridDim.x * gridDim.y * gridDim.z;
    unsigned sum, cnt, mine, sp = 0u;
    for (;;) {
        sum = 0u; cnt = 0u; mine = 0u;
#pragma unroll
        for (unsigned j = 0; j < 16; ++j) { const unsigned c = xb_ld(&bar[XB_XCNT(j)]); sum += c; cnt += (c > 0u) ? 1u : 0u; mine = (j == x) ? c : mine; }
        if (sum == G) break;
        __builtin_amdgcn_s_sleep(1);
        if ((++sp & 255u) == 0u) { if (xb_ld(&bar[XB_TMO])) break; if (sp > XB_SPIN_CAP) { atomicAdd(&bar[XB_TMO], 1u); break; } }
    }
    nloc = mine > 0u ? mine : 1u; nx = cnt > 0u ? cnt : 1u;
}

__device__ __forceinline__ void xcd_barrier(const XcdBarrier& b) {
    asm volatile("s_waitcnt vmcnt(0)" ::: "memory");
    __syncthreads();
    if (threadIdx.x == 0) {
        unsigned* bar = b.bar;
        __builtin_amdgcn_s_waitcnt(0);
        unsigned nloc = b.st[0], nx = b.st[1];
        if (nloc == 0u) { xcd_barrier_complete(bar, b.x, nloc, nx); b.st[0] = nloc; b.st[1] = nx; }
        const unsigned old = xb_add(&bar[XB_XSUB(b.x)], 1u);
        const unsigned gen = old / nloc;
        if (old + 1u == (gen + 1u) * nloc) {
            __builtin_amdgcn_fence(__ATOMIC_RELEASE, "agent");
            asm volatile("s_waitcnt vmcnt(0)" ::: "memory");
            const unsigned og = xb_add(&bar[XB_TOP], 1u);
            const unsigned tg = og / nx;
            if (og + 1u == (tg + 1u) * nx) xb_add(&bar[XB_TOPGEN], 1u);
            else XB_SPIN(xb_ld(&bar[XB_TOPGEN]) == tg, bar);
            __builtin_amdgcn_fence(__ATOMIC_ACQUIRE, "agent");
            xb_add(&bar[XB_XGEN(b.x)], 1u);
            asm volatile("s_waitcnt vmcnt(0)" ::: "memory");
        } else {
            XB_SPIN(xb_ld(&bar[XB_XGEN(b.x)]) == gen, bar);
            __builtin_amdgcn_fence(__ATOMIC_ACQUIRE, "agent");
            asm volatile("s_waitcnt vmcnt(0)" ::: "memory");
        }
    }
    __syncthreads();
}

constexpr int NWAVES = 8;
constexpr int D = 4096, BATCH = 4, SEQ = 2048, NMETA = 16, TP = SEQ + NMETA, MPROMPT = BATCH * TP;
constexpr int DEC_B = 128, DEC_T = 4, MSAMP = DEC_B * DEC_T, MTOT = MPROMPT + MSAMP, MP = 8960;
constexpr int MC = BATCH * SEQ + MSAMP;
constexpr int GH = 4, DK = 256, DV = 512, QK = 1024, GW = 2048, RANK = 16;
constexpr int SW = 2048, HD = 64, SH = 32, SG = 8, NS = 128, CONV_DIM = 4096;
constexpr int DFF = 16384, DIN = 12336;
constexpr int NU = 12288, NIN_PAD = 12544;
constexpr int UC_Q = 0, UC_K = 1024, UC_V = 2048, UC_R = 4096, UC_Z = 6144, UC_XBC = 8192;
constexpr float ALPHA = 1.189207115002721f, EPS = 1e-5f;

constexpr size_t MiB = 1u << 20;
constexpr size_t WS_CTL = 0, CTL_ZERO_BYTES = 32768;
constexpr size_t WS_WIN = 1 * MiB, WS_WOUT = 99 * MiB, WS_WUP = 131 * MiB, WS_WDN = 259 * MiB;
constexpr size_t WS_XB = 387 * MiB;
constexpr size_t WS_U = 457 * MiB, WS_UT = 667 * MiB, WS_EG = 670 * MiB, WS_DTA = 705 * MiB, WS_XC = 708 * MiB, WS_OY = 845 * MiB;
constexpr size_t WS_MIX = 982 * MiB, WS_HB = 1052 * MiB, WS_END = 1122 * MiB;
constexpr size_t WS_GIMG = WS_MIX;
constexpr size_t WS_PRE1 = WS_XC;
constexpr size_t WS_PRE2 = WS_MIX;
constexpr size_t WS_SLAB = WS_OY;
constexpr size_t WS_HID = WS_U;
static_assert(WS_WIN + (size_t)NIN_PAD * D * 2 <= WS_WOUT && WS_XB + (size_t)MP * D * 2 <= WS_U && WS_U + (size_t)MP * NU * 2 <= WS_UT && WS_UT + (size_t)MP * 64 * 4 <= WS_EG, "ws map 1");
static_assert(WS_EG + (size_t)MTOT * 1024 * 4 <= WS_DTA && WS_DTA + (size_t)MTOT * 64 * 4 <= WS_XC && WS_XC + (size_t)MTOT * D * 4 <= WS_OY && WS_OY + (size_t)MTOT * D * 4 <= WS_MIX  , "ws map 2");
static_assert(WS_MIX + (size_t)MP * D * 2 <= WS_HB && WS_HB + (size_t)MP * D * 2 <= WS_END && WS_HID + (size_t)MP * DFF * 2 <= WS_OY, "ws map 3");
constexpr int CW_TMO = 0, CW_Q = 64, CW_CV0 = 256, CW_CV1 = 320, CW_P2Q = 384, CW_BAR = 4096;
static_assert((CW_BAR + 3456) * 4 <= (int)CTL_ZERO_BYTES, "control words inside the per-launch memset");

constexpr size_t O_YP = 0, O_YS = O_YP + (size_t)BATCH * SEQ * D, O_GP = O_YS + (size_t)MSAMP * D, O_SP = O_GP + (size_t)BATCH * GH * DK * DV,
                 O_CP = O_SP + (size_t)BATCH * SH * HD * NS, O_GS = O_CP + (size_t)BATCH * 3 * CONV_DIM, O_SS = O_GS + (size_t)DEC_B * GH * DK * DV,
                 O_CS = O_SS + (size_t)DEC_B * SH * HD * NS, O_END = O_CS + (size_t)DEC_B * 3 * CONV_DIM;

constexpr int RING_OFF = 0, RING_BYTES = 131072;
constexpr int LDSCTL_OFF = 157696, MISC_OFF = LDSCTL_OFF + 320;
constexpr int LDS_BYTES = LDSCTL_OFF + 1024;

typedef float f32x2 __attribute__((ext_vector_type(2)));
__device__ __forceinline__ float bf_lo(unsigned w) { return __uint_as_float(w << 16); }
__device__ __forceinline__ float bf_hi(unsigned w) { return __uint_as_float(w & 0xffff0000u); }
template <int CTRL> __device__ __forceinline__ float dppf(float x) { return __builtin_bit_cast(float, __builtin_amdgcn_update_dpp(0, __builtin_bit_cast(int, x), CTRL, 0xf, 0xf, false)); }
__device__ __forceinline__ float row_allreduce(float x) { x += dppf<0x128>(x); x += dppf<0x124>(x); x += dppf<0x122>(x); x += dppf<0x121>(x); return x; }
__device__ __forceinline__ float half_row_allreduce(float x) { x += dppf<0x141>(x); x += dppf<0x4E>(x); x += dppf<0xB1>(x); return x; }
__device__ __forceinline__ void swap16(float& a, float& b) { asm("s_nop 1\n\tv_permlane16_swap_b32 %0, %1" : "+v"(a), "+v"(b)); }
__device__ __forceinline__ void swap32(float& a, float& b) { asm("s_nop 1\n\tv_permlane32_swap_b32 %0, %1" : "+v"(a), "+v"(b)); }
__device__ __forceinline__ float wave_sum(float v) { v = row_allreduce(v); float a = v, b = v; swap16(a, b); v = a + b; a = v; b = v; swap32(a, b); return a + b; }
__device__ __forceinline__ float silu_f(float x) { return x * __builtin_amdgcn_rcpf(1.f + __expf(-x)); }
__device__ __forceinline__ float softplus_f(float x) { return fmaxf(x, 0.f) + __logf(1.f + __expf(-fabsf(x))); }

struct Args { const float* in[23]; float* out; unsigned char* ws; int ph_lo, ph_hi; };
__device__ __forceinline__ int opaque_lane(int tid) { int l; asm volatile("v_and_b32 %0, 63, %1" : "=v"(l) : "v"(tid)); return l; }

__device__ __forceinline__ void transpose_item(const float* W, int ldw, int K, int k0, int nsrc, bf16* WT, int ndst, int nvalid, LAS float* scr, int lane) {
    float wv[32];
#pragma unroll
    for (int i = 0; i < 32; ++i) { const int kk = 2 * i + (lane >> 5); wv[i] = __builtin_nontemporal_load(W + (size_t)(k0 + kk) * ldw + nsrc + (lane & 31)); }
#pragma unroll
    for (int i = 0; i < 32; ++i) { const int kk = 2 * i + (lane >> 5); scr[kk * 33 + (lane & 31)] = wv[i]; }
    LDS_WAIT(); asm volatile("" ::: "memory");
    const int c = lane & 7;
#pragma unroll
    for (int j = 0; j < 4; ++j) { const int n = (lane >> 3) + 8 * j; const LAS float* s = scr + (8 * c) * 33 + n;
        v4u o; o.x = pk2(s[0 * 33], s[1 * 33]); o.y = pk2(s[2 * 33], s[3 * 33]); o.z = pk2(s[4 * 33], s[5 * 33]); o.w = pk2(s[6 * 33], s[7 * 33]);
        if (n < nvalid) __builtin_nontemporal_store(o, (GAS v4u*)(WT + (size_t)(ndst + n) * K + k0 + 8 * c)); }
    LDS_WAIT(); asm volatile("" ::: "memory");
}
__device__ __forceinline__ void p0_prologue(const Args& A, LAS unsigned char* lds, int tid, int lane, int wave, int G) {
    unsigned char* ws = A.ws;
    bf16* WIN = (bf16*)(ws + WS_WIN); bf16* XB = (bf16*)(ws + WS_XB);
    const float* w_in = A.in[6];
    LAS float* scr = (LAS float*)(lds + RING_OFF + wave * 16384);
    const int gw = wave * G + blockIdx.x, NGW = G * NWAVES;
    constexpr int NB_IN = 386, I_IN = (D / 64) * NB_IN;
#define P0_DECODE(it, k0, nsrc, ndst, nv) do { const int kb_ = (it) / NB_IN, nb_ = (it) - kb_ * NB_IN; k0 = 64 * kb_; nv = 32; \
        if (nb_ < 192) { nsrc = 32 * nb_; ndst = nsrc; } else if (nb_ == 192) { nsrc = 6144; ndst = 12288; nv = 16; } else if (nb_ < 385) { nsrc = 6160 + 32 * (nb_ - 193); ndst = 6144 + 32 * (nb_ - 193); } else { nsrc = 12304; ndst = 12304; } } while (0)
#define P0_LOAD(dst, k0, nsrc) do { _Pragma("unroll") for (int i = 0; i < 32; ++i) dst[i] = __builtin_nontemporal_load(w_in + (size_t)((k0) + 2 * i + (lane >> 5)) * DIN + (nsrc) + (lane & 31)); } while (0)
    if (gw < I_IN) {
        float wv[32], wn[32]; int k0, nsrc, ndst, nv;
        P0_DECODE(gw, k0, nsrc, ndst, nv); P0_LOAD(wv, k0, nsrc);
        for (int it = gw; it < I_IN; it += NGW) {
            const int itn = it + NGW < I_IN ? it + NGW : it; int k0n, nsrcn, ndstn, nvn;
            P0_DECODE(itn, k0n, nsrcn, ndstn, nvn); P0_LOAD(wn, k0n, nsrcn);
#pragma unroll
            for (int i = 0; i < 32; ++i) scr[(2 * i + (lane >> 5)) * 33 + (lane & 31)] = wv[i];
            LDS_WAIT(); asm volatile("" ::: "memory");
            const int c = lane & 7;
#pragma unroll
            for (int j = 0; j < 4; ++j) { const int n = (lane >> 3) + 8 * j; const LAS float* sp = scr + (8 * c) * 33 + n;
                v4u o; o.x = pk2(sp[0 * 33], sp[1 * 33]); o.y = pk2(sp[2 * 33], sp[3 * 33]); o.z = pk2(sp[4 * 33], sp[5 * 33]); o.w = pk2(sp[6 * 33], sp[7 * 33]);
                if (n < nv) *(GAS v4u*)(WIN + (size_t)(ndst + n) * D + k0 + 8 * c) = o; }
            LDS_WAIT(); asm volatile("" ::: "memory");
#pragma unroll
            for (int i = 0; i < 32; ++i) wv[i] = wn[i];
            k0 = k0n; nsrc = nsrcn; ndst = ndstn; nv = nvn;
        }
    }
#undef P0_DECODE
#undef P0_LOAD
    { const size_t n16 = (size_t)(NIN_PAD - DIN) * D * 2 / 16; GAS v4u* z = (GAS v4u*)(WIN + (size_t)DIN * D);
      for (size_t i = (size_t)blockIdx.x * 512 + tid; i < n16; i += (size_t)G * 512) z[i] = (v4u){0u, 0u, 0u, 0u}; }
    pg8::RowMap rm{A.in[0], A.in[1], A.in[5], nullptr, TP, NMETA, SEQ, MPROMPT, MTOT, D};
#define XB_LOAD(dst, r_) do { const int rr_ = (r_) < MTOT ? (r_) : MTOT - 1; const GAS f32x4* xr_ = (const GAS f32x4*)rm.src(rr_) + lane; \
        _Pragma("unroll") for (int j_ = 0; j_ < 16; ++j_) dst[j_] = __builtin_nontemporal_load(xr_ + 64 * j_); } while (0)
    if (gw < MP) { f32x4 cur[16], nx[16]; XB_LOAD(cur, gw);
        for (int r = gw; r < MP; r += NGW) { const int rn = r + NGW < MP ? r + NGW : r; XB_LOAD(nx, rn);
            GAS unsigned long long* o8 = (GAS unsigned long long*)(XB + (size_t)r * D) + lane; const bool real = r < MTOT;
#pragma unroll
            for (int j = 0; j < 16; ++j) { const f32x4 v = cur[j]; const unsigned long long pk = (unsigned long long)pk2(v.x, v.y) | ((unsigned long long)pk2(v.z, v.w) << 32); o8[64 * j] = real ? pk : 0ull; }
#pragma unroll
            for (int j = 0; j < 16; ++j) cur[j] = nx[j]; } }
#undef XB_LOAD
}

constexpr int CV_OUT = (D / 64) * (D / 32), CV_UP = (D / 64) * (DFF / 32), CV_DN = (DFF / 64) * (D / 32), CV_BATCH = 4;
__device__ __forceinline__ void convert_queue(const Args& A, LAS unsigned char* lds, int lane, int wave, gu32* ctr, int which) {
    unsigned char* ws = A.ws;
    bf16* WOUT = (bf16*)(ws + WS_WOUT); bf16* WUP = (bf16*)(ws + WS_WUP); bf16* WDN = (bf16*)(ws + WS_WDN);
    const float* w_out = A.in[16]; const float* w_up = A.in[19]; const float* w_down = A.in[20];
    LAS float* scr = (LAS float*)(lds + RING_OFF + wave * 16384);
    const int nitems = which == 0 ? CV_OUT + CV_UP : CV_DN;
    for (;;) {
        unsigned b0 = 0u; if (lane == 0) b0 = __hip_atomic_fetch_add((unsigned*)ctr, 1u, __ATOMIC_RELAXED, __HIP_MEMORY_SCOPE_AGENT);
        const int base = (int)__builtin_amdgcn_readfirstlane(b0) * CV_BATCH;
        if (base >= nitems) break;
        for (int q = 0; q < CV_BATCH; ++q) { int r = base + q;
            if (which == 0) {
                if (r < CV_OUT) { const int kb = r / (D / 32), nb = r - kb * (D / 32); transpose_item(w_out, D, D, 64 * kb, 32 * nb, WOUT, 32 * nb, 32, scr, lane); }
                else { r -= CV_OUT; const int kb = r / (DFF / 32), nb = r - kb * (DFF / 32); transpose_item(w_up, DFF, D, 64 * kb, 32 * nb, WUP, 32 * nb, 32, scr, lane); }
            } else { const int kb = r / (D / 32), nb = r - kb * (D / 32); transpose_item(w_down, D, DFF, 64 * kb, 32 * nb, WDN, 32 * nb, 32, scr, lane); } }
    }
}

__device__ __forceinline__ void gla_image_unit(const Args& A, LAS unsigned char* lds, int tid, int b, int h, int c);
__device__ __forceinline__ void p2_prepass(const Args& A, LAS unsigned char* lds, int tid, int G, gu32* ctl, volatile LAS unsigned* MISC) {
    unsigned char* ws = A.ws;
    const bf16* U = (const bf16*)(ws + WS_U); const float* UT = (const float*)(ws + WS_UT); float* EG = (float*)(ws + WS_EG); float* DTA = (float*)(ws + WS_DTA); bf16* XC = (bf16*)(ws + WS_XC);
    const float* state_conv = A.in[4]; const float* w_gk_up = A.in[7]; const float* b_gk = A.in[8]; const float* conv_w = A.in[10]; const float* conv_b = A.in[11];
    const float* dt_bias = A.in[12]; const float* a_log = A.in[13];
    LAS float* uts = (LAS float*)(lds + RING_OFF);
    float wg0[RANK], wg1[RANK];
#pragma unroll
    for (int j = 0; j < RANK; ++j) { const f32x2 w = *(const f32x2*)(w_gk_up + j * QK + 2 * tid); wg0[j] = w.x; wg1[j] = w.y; }
    const f32x2 bg = *(const f32x2*)(b_gk + 2 * tid);
    float cw[4][8], cb[8];
#pragma unroll
    for (int j = 0; j < 4; ++j) { const f32x4 a = *(const f32x4*)(conv_w + j * CONV_DIM + 8 * tid), b = *(const f32x4*)(conv_w + j * CONV_DIM + 8 * tid + 4);
        cw[j][0] = a.x; cw[j][1] = a.y; cw[j][2] = a.z; cw[j][3] = a.w; cw[j][4] = b.x; cw[j][5] = b.y; cw[j][6] = b.z; cw[j][7] = b.w; }
    { const f32x4 a = *(const f32x4*)(conv_b + 8 * tid), b = *(const f32x4*)(conv_b + 8 * tid + 4); cb[0] = a.x; cb[1] = a.y; cb[2] = a.z; cb[3] = a.w; cb[4] = b.x; cb[5] = b.y; cb[6] = b.z; cb[7] = b.w; }
    const int hd = tid & 31; const float dtb = dt_bias[hd], aneg = -expf(a_log[hd]);
    constexpr int NRUN_P = BATCH * (TP / 16), NUNITS = NRUN_P + DEC_B;
    static_assert(TP % 16 == 0, "prompt runs");
    constexpr int NIMG = BATCH * 4 * ((TP + 63) / 64);
    unsigned qnext = 0u; if (tid == 0) qnext = __hip_atomic_fetch_add((unsigned*)(ctl + CW_P2Q), 1u, __ATOMIC_RELAXED, __HIP_MEMORY_SCOPE_AGENT);
    for (;;) {
        if (tid == 0) MISC[1] = qnext;
        __syncthreads(); const int it0 = (int)MISC[1]; __syncthreads();
        if (it0 >= NIMG + NRUN_P + DEC_B) break;
        if (tid == 0) qnext = __hip_atomic_fetch_add((unsigned*)(ctl + CW_P2Q), 1u, __ATOMIC_RELAXED, __HIP_MEMORY_SCOPE_AGENT);
        if (it0 < NIMG) { const int nck = (TP + 63) / 64, bh = (it0 & 7) + 8 * ((it0 >> 3) / nck), c = (it0 >> 3) % nck; gla_image_unit(A, lds, tid, bh >> 2, bh & 3, c); continue; }
        const int u = it0 - NIMG; const bool doB = true, doA = u >= NRUN_P;
        int r0, t0, L, rseq; const float* hist = nullptr;
        if (u < NRUN_P) { const int b = u / (TP / 16), c = u - b * (TP / 16); rseq = b * TP; t0 = 16 * c; r0 = rseq + t0; L = 16; }
        else { const int s = u - NRUN_P; rseq = MPROMPT + 4 * s; t0 = 0; r0 = rseq; L = 4; hist = state_conv + (size_t)s * 3 * CONV_DIM; }
        if (doA) {
        for (int i = tid; i < L * 64; i += 512) uts[i] = UT[(size_t)r0 * 64 + i];
        __syncthreads();
        { float c0s = 0.f, c1s = 0.f;
#pragma unroll 2
          for (int i = 0; i < L; ++i) { float z0 = bg.x, z1 = bg.y;
            const f32x4 u0 = *(const LAS f32x4*)(uts + i * 64), u1 = *(const LAS f32x4*)(uts + i * 64 + 4), u2 = *(const LAS f32x4*)(uts + i * 64 + 8), u3 = *(const LAS f32x4*)(uts + i * 64 + 12);
            const float ux[RANK] = {u0.x, u0.y, u0.z, u0.w, u1.x, u1.y, u1.z, u1.w, u2.x, u2.y, u2.z, u2.w, u3.x, u3.y, u3.z, u3.w};
#pragma unroll
            for (int j = 0; j < RANK; ++j) { z0 += ux[j] * wg0[j]; z1 += ux[j] * wg1[j]; }
            const float g0 = -softplus_f(-z0) * (1.f / 16.f), g1 = -softplus_f(-z1) * (1.f / 16.f); c0s += g0; c1s += g1;
            f32x2 e; if (hist) { e.x = expf(g0); e.y = expf(g1); } else { e.x = c0s; e.y = c1s; }
            *(f32x2*)(EG + (size_t)(r0 + i) * QK + 2 * tid) = e; } }
        if (hist) { if (tid < 32 * L) { const int i = tid >> 5; const float dt = softplus_f(uts[i * 64 + 16 + hd] + dtb); DTA[(size_t)(r0 + i) * 64 + hd] = dt; DTA[(size_t)(r0 + i) * 64 + 32 + hd] = expf(dt * aneg); } }
        else if (tid < 32) { float cs = 0.f; for (int i = 0; i < L; ++i) { const float dt = softplus_f(uts[i * 64 + 16 + hd] + dtb); cs += dt * aneg; DTA[(size_t)(r0 + i) * 64 + hd] = dt; DTA[(size_t)(r0 + i) * 64 + 32 + hd] = cs; } }
        }
        if (!doA && tid < 32) {
            float dv[16];
#pragma unroll
            for (int i = 0; i < 16; ++i) dv[i] = UT[(size_t)(r0 + i) * 64 + 16 + hd];
            float cs = 0.f;
#pragma unroll
            for (int i = 0; i < 16; ++i) { const float dt = softplus_f(dv[i] + dtb); cs += dt * aneg; DTA[(size_t)(r0 + i) * 64 + hd] = dt; DTA[(size_t)(r0 + i) * 64 + 32 + hd] = cs; } }
        if (doB) { float xh[3][8];
#pragma unroll
          for (int j = 0; j < 3; ++j) { const int tau = t0 - 3 + j;
              if (tau >= 0) { const v4u w = *(const v4u*)(U + (size_t)(rseq + tau) * NU + UC_XBC + 8 * tid);
                  xh[j][0] = bf_lo(w.x); xh[j][1] = bf_hi(w.x); xh[j][2] = bf_lo(w.y); xh[j][3] = bf_hi(w.y); xh[j][4] = bf_lo(w.z); xh[j][5] = bf_hi(w.z); xh[j][6] = bf_lo(w.w); xh[j][7] = bf_hi(w.w); }
              else if (hist) { const f32x4 a = *(const f32x4*)(hist + (size_t)(3 + tau) * CONV_DIM + 8 * tid), b = *(const f32x4*)(hist + (size_t)(3 + tau) * CONV_DIM + 8 * tid + 4);
                  xh[j][0] = a.x; xh[j][1] = a.y; xh[j][2] = a.z; xh[j][3] = a.w; xh[j][4] = b.x; xh[j][5] = b.y; xh[j][6] = b.z; xh[j][7] = b.w; }
              else {
#pragma unroll
                  for (int e = 0; e < 8; ++e) xh[j][e] = 0.f; } }
          const bf16* urow = U + (size_t)r0 * NU + UC_XBC + 8 * tid; v4u wc[4], wn[4];
#pragma unroll
          for (int q = 0; q < 4; ++q) wc[q] = *(const v4u*)(urow + (size_t)q * NU);
          for (int i0 = 0; i0 < L; i0 += 4) { const int in = (i0 + 4 < L) ? i0 + 4 : i0;
#pragma unroll
              for (int q = 0; q < 4; ++q) wn[q] = *(const v4u*)(urow + (size_t)(in + q) * NU);
#pragma unroll
              for (int q = 0; q < 4; ++q) { const v4u w = wc[q]; float x3[8];
                  x3[0] = bf_lo(w.x); x3[1] = bf_hi(w.x); x3[2] = bf_lo(w.y); x3[3] = bf_hi(w.y); x3[4] = bf_lo(w.z); x3[5] = bf_hi(w.z); x3[6] = bf_lo(w.w); x3[7] = bf_hi(w.w);
                  float o[8];
#pragma unroll
                  for (int e = 0; e < 8; ++e) { const float v = cb[e] + cw[0][e] * xh[0][e] + cw[1][e] * xh[1][e] + cw[2][e] * xh[2][e] + cw[3][e] * x3[e]; o[e] = silu_f(v); xh[0][e] = xh[1][e]; xh[1][e] = xh[2][e]; xh[2][e] = x3[e]; }
                  v4u ow; ow.x = pk2(o[0], o[1]); ow.y = pk2(o[2], o[3]); ow.z = pk2(o[4], o[5]); ow.w = pk2(o[6], o[7]); *(v4u*)(XC + (size_t)(r0 + i0 + q) * CONV_DIM + 8 * tid) = ow; }
#pragma unroll
              for (int q = 0; q < 4; ++q) wc[q] = wn[q]; } }
    }
    for (int u = blockIdx.x; u < (BATCH + DEC_B) * 3; u += G) { const int sq = u / 3, i = u - 3 * sq; int r; float* o;
        if (sq < BATCH) { r = sq * TP + TP - 3 + i; o = A.out + O_CP + (size_t)(sq * 3 + i) * CONV_DIM; } else { const int s = sq - BATCH; r = MPROMPT + 4 * s + 1 + i; o = A.out + O_CS + (size_t)(s * 3 + i) * CONV_DIM; }
        const v4u w = *(const v4u*)(U + (size_t)r * NU + UC_XBC + 8 * tid);
        *(f32x4*)(o + 8 * tid) = (f32x4){bf_lo(w.x), bf_hi(w.x), bf_lo(w.y), bf_hi(w.y)}; *(f32x4*)(o + 8 * tid + 4) = (f32x4){bf_lo(w.z), bf_hi(w.z), bf_lo(w.w), bf_hi(w.w)}; }
}

typedef short bf16x8v __attribute__((ext_vector_type(8)));
constexpr int GC = 64, GVS = 64, QT_LD = 264, KH_LD = 72, VT_LD = 72, AS_LD = 72, ST_LD = 264;
constexpr int GL_QT = 0, GL_DL = GL_QT + GC * QT_LD * 2, GL_KH = GL_DL + 1024, GL_AS = GL_KH + 256 * KH_LD * 2, GL_VT = GL_AS + GC * AS_LD * 2, GL_ST = GL_VT + GVS * VT_LD * 2, GL_END = GL_ST + GVS * ST_LD * 2;
constexpr int GIMG_BYTES = GL_VT, GIMG_A = GL_DL, GIMG_B = GL_VT - GL_DL, NCHUNK = (TP + GC - 1) / GC;
static_assert(GL_END <= LDSCTL_OFF && GIMG_A % 1024 == 0 && GIMG_B % 1024 == 0, "GLA LDS map");
__device__ __forceinline__ f32x4 mfma16(bf16x8v a, bf16x8v b, f32x4 c) { return __builtin_amdgcn_mfma_f32_16x16x32_bf16(a, b, c, 0, 0, 0); }
constexpr int GI_BL = GL_KH, GI_KT = GI_BL + GC * 256 * 4, GI_UT = GI_KT + GC * QT_LD * 2;
static_assert(GI_UT + GC * 16 * 4 <= LDSCTL_OFF && GI_BL + GC * 256 * 4 >= GL_VT, "image unit LDS map");
__device__ __forceinline__ void gla_image_unit(const Args& A, LAS unsigned char* lds, int tid, int b, int h, int c) {
    unsigned char* ws = A.ws;
    const bf16* U = (const bf16*)(ws + WS_U); const float* UT = (const float*)(ws + WS_UT);
    LAS bf16* Qt = (LAS bf16*)(lds + GL_QT); LAS bf16* Kt = (LAS bf16*)(lds + GI_KT); LAS bf16* KHt = (LAS bf16*)(lds + GL_KH); LAS float* DL = (LAS float*)(lds + GL_DL); LAS bf16* As = (LAS bf16*)(lds + GL_AS);
    LAS float* BL = (LAS float*)(lds + GI_BL); LAS float* uts = (LAS float*)(lds + GI_UT);
    const int koct = tid & 31, trow = tid >> 5, rb = b * TP + c * GC, nvalid = (TP - c * GC) < GC ? (TP - c * GC) : GC;
    v4u qra[4], kra[4];
#pragma unroll
    for (int i = 0; i < 4; ++i) { const bf16* up = U + (size_t)(rb + trow + 16 * i) * NU + h * DK + 8 * koct; qra[i] = *(const v4u*)(up + UC_Q); kra[i] = *(const v4u*)(up + UC_K); }
    float wk[RANK];
#pragma unroll
    for (int j = 0; j < RANK; ++j) wk[j] = A.in[7][j * QK + h * DK + (tid & 255)];
    const float bgk = A.in[8][h * DK + (tid & 255)];
    if (tid < 256) *(LAS f32x4*)(uts + 4 * tid) = *(const f32x4*)(UT + (size_t)(rb + (tid >> 2)) * 64 + 4 * (tid & 3));
    __syncthreads();
    { const int k = tid & 255, half = tid >> 8;
#pragma unroll
      for (int rr = 0; rr < 2; ++rr) { float cs = 0.f;
#pragma unroll 4
          for (int i = 0; i < 16; ++i) { const int t = 32 * half + 16 * rr + i;
              const f32x4 u0 = *(const LAS f32x4*)(uts + t * 16), u1 = *(const LAS f32x4*)(uts + t * 16 + 4), u2 = *(const LAS f32x4*)(uts + t * 16 + 8), u3 = *(const LAS f32x4*)(uts + t * 16 + 12);
              const float ux[RANK] = {u0.x, u0.y, u0.z, u0.w, u1.x, u1.y, u1.z, u1.w, u2.x, u2.y, u2.z, u2.w, u3.x, u3.y, u3.z, u3.w};
              float z = bgk;
#pragma unroll
              for (int j = 0; j < RANK; ++j) z += ux[j] * wk[j];
              cs += -softplus_f(-z) * (1.f / 16.f); BL[t * 256 + k] = cs; } } }
    __syncthreads();
    { f32x4 p0 = (f32x4){0.f, 0.f, 0.f, 0.f}, p1 = p0;
#pragma unroll
      for (int i = 0; i < 4; ++i) { const int t = trow + 16 * i; const bool ok = t < nvalid; const size_t row = (size_t)(rb + t);
          const LAS float* e = BL + t * 256 + 8 * koct; const f32x4 b0 = *(const LAS f32x4*)e + p0, b1 = *(const LAS f32x4*)(e + 4) + p1;
          const LAS float* pe = BL + (16 * i + 15) * 256 + 8 * koct; const f32x4 pr0 = *(const LAS f32x4*)pe, pr1 = *(const LAS f32x4*)(pe + 4);
          const v4u qr = qra[i], kr = kra[i];
          float eb[8], en[8]; const float bb[8] = {b0.x, b0.y, b0.z, b0.w, b1.x, b1.y, b1.z, b1.w};
#pragma unroll
          for (int e2 = 0; e2 < 8; ++e2) { eb[e2] = __expf(bb[e2]); en[e2] = __builtin_amdgcn_rcpf(eb[e2]); }
          const float qf[8] = {bf_lo(qr.x), bf_hi(qr.x), bf_lo(qr.y), bf_hi(qr.y), bf_lo(qr.z), bf_hi(qr.z), bf_lo(qr.w), bf_hi(qr.w)};
          const float kf[8] = {bf_lo(kr.x), bf_hi(kr.x), bf_lo(kr.y), bf_hi(kr.y), bf_lo(kr.z), bf_hi(kr.z), bf_lo(kr.w), bf_hi(kr.w)};
          v4u qo, ko;
          qo.x = pk2(qf[0] * eb[0] * 0.0625f, qf[1] * eb[1] * 0.0625f); qo.y = pk2(qf[2] * eb[2] * 0.0625f, qf[3] * eb[3] * 0.0625f); qo.z = pk2(qf[4] * eb[4] * 0.0625f, qf[5] * eb[5] * 0.0625f); qo.w = pk2(qf[6] * eb[6] * 0.0625f, qf[7] * eb[7] * 0.0625f);
          ko.x = pk2(kf[0] * en[0], kf[1] * en[1]); ko.y = pk2(kf[2] * en[2], kf[3] * en[3]); ko.z = pk2(kf[4] * en[4], kf[5] * en[5]); ko.w = pk2(kf[6] * en[6], kf[7] * en[7]);
          if (!ok) { qo = (v4u){0u, 0u, 0u, 0u}; ko = qo; }
          *(LAS v4u*)(Qt + t * QT_LD + 8 * koct) = qo; *(LAS v4u*)(Kt + t * QT_LD + 8 * koct) = ko;
          if (16 * (i + 1) <= nvalid) { p0 = p0 + pr0; p1 = p1 + pr1; } }
      if (trow == 0) { *(LAS f32x4*)(DL + 8 * koct) = (f32x4){__expf(p0.x), __expf(p0.y), __expf(p0.z), __expf(p0.w)}; *(LAS f32x4*)(DL + 8 * koct + 4) = (f32x4){__expf(p1.x), __expf(p1.y), __expf(p1.z), __expf(p1.w)}; } }
    if (tid < 128) { *(LAS unsigned long long*)((LAS unsigned char*)Qt + (tid >> 1) * (QT_LD * 2) + 512 + 8 * (tid & 1)) = 0ull; *(LAS unsigned long long*)((LAS unsigned char*)Kt + (tid >> 1) * (QT_LD * 2) + 512 + 8 * (tid & 1)) = 0ull; }
    __syncthreads();
#pragma unroll
    for (int i = 0; i < 4; ++i) { const int idx = tid + 512 * i, k = idx & 255, toct = idx >> 8; unsigned short e[8];
#pragma unroll
        for (int jj = 0; jj < 8; ++jj) e[jj] = Kt[(8 * toct + jj) * QT_LD + k];
        v4u o; o.x = (unsigned)e[0] | ((unsigned)e[1] << 16); o.y = (unsigned)e[2] | ((unsigned)e[3] << 16); o.z = (unsigned)e[4] | ((unsigned)e[5] << 16); o.w = (unsigned)e[6] | ((unsigned)e[7] << 16);
        *(LAS v4u*)(KHt + k * KH_LD + 8 * toct) = o; }
    if (tid < 256) *(LAS v4u*)(KHt + tid * KH_LD + 64) = (v4u){0u, 0u, 0u, 0u};
    { const int lane = tid & 63, w = tid >> 6, r16 = lane & 15, g4 = lane >> 4, ti = w >> 1, sb = 2 * (w & 1);
      f32x4 sc0 = (f32x4){0.f, 0.f, 0.f, 0.f}, sc1 = sc0;
      const LAS bf16* qrow = Qt + (16 * ti + r16) * QT_LD + 8 * g4; const LAS bf16* k0row = Kt + (16 * sb + r16) * QT_LD + 8 * g4; const LAS bf16* k1row = k0row + 16 * QT_LD;
#pragma unroll
      for (int ks = 0; ks < 8; ++ks) { const bf16x8v qf = *(const LAS bf16x8v*)(qrow + 32 * ks);
          if (sb <= ti) sc0 = mfma16(*(const LAS bf16x8v*)(k0row + 32 * ks), qf, sc0);
          if (sb + 1 <= ti) sc1 = mfma16(*(const LAS bf16x8v*)(k1row + 32 * ks), qf, sc1); }
      const int t = 16 * ti + r16;
#pragma unroll
      for (int q = 0; q < 2; ++q) { const int s0 = 16 * (sb + q) + 4 * g4; const f32x4 d = q ? sc1 : sc0;
          pg8::u32x2 o; o.x = pk2(s0 <= t ? d.x : 0.f, s0 + 1 <= t ? d.y : 0.f); o.y = pk2(s0 + 2 <= t ? d.z : 0.f, s0 + 3 <= t ? d.w : 0.f);
          *(LAS pg8::u32x2*)(As + t * AS_LD + s0) = o; }
      if (tid < 64) *(LAS v4u*)(As + tid * AS_LD + 64) = (v4u){0u, 0u, 0u, 0u}; }
    __syncthreads();
    GAS v4u* img = (GAS v4u*)(ws + WS_GIMG + (size_t)((b * GH + h) * NCHUNK + c) * GIMG_BYTES);
    for (int i = tid; i < GIMG_BYTES / 16; i += 512) img[i] = *(const LAS v4u*)(lds + 16 * i);
    __syncthreads();
}
__device__ __forceinline__ void gla_prompt_unit(const Args& A, LAS unsigned char* lds, int tid, int lane, int w, int b, int h, int vs) {
    unsigned char* ws = A.ws;
    const bf16* U = (const bf16*)(ws + WS_U); bf16* OY = (bf16*)(ws + WS_OY);
    LAS bf16* Qt = (LAS bf16*)(lds + GL_QT); LAS bf16* KHt = (LAS bf16*)(lds + GL_KH); LAS bf16* Vt = (LAS bf16*)(lds + GL_VT);
    LAS bf16* As = (LAS bf16*)(lds + GL_AS); LAS bf16* St = (LAS bf16*)(lds + GL_ST); LAS float* DL = (LAS float*)(lds + GL_DL);
    const int r16 = lane & 15, g4 = lane >> 4;
    f32x4 S[2][4];
#pragma unroll
    for (int i = 0; i < 2; ++i)
#pragma unroll
        for (int j = 0; j < 4; ++j) S[i][j] = (f32x4){0.f, 0.f, 0.f, 0.f};
    for (int i = tid; i < GVS * ST_LD / 2; i += 512) ((LAS unsigned*)St)[i] = 0u;
    const unsigned char* img0 = ws + WS_GIMG + (size_t)((b * GH + h) * NCHUNK) * GIMG_BYTES;
#define GLA_DMA(img, off, nbytes) do { for (int q_ = w; q_ < (nbytes) / 1024; q_ += 8) { \
        const unsigned char* gp_ = (img) + (off) + q_ * 1024 + lane * 16; const unsigned la_ = (unsigned)__builtin_amdgcn_readfirstlane((int)(unsigned)(size_t)(lds + (off) + q_ * 1024)); \
        unsigned m0s_; asm volatile("s_mov_b32 %0, m0\n\ts_mov_b32 m0, %2\n\ts_nop 0\n\tglobal_load_lds_dwordx4 %1, off\n\ts_mov_b32 m0, %0" : "=&s"(m0s_) : "v"(gp_), "s"(la_) : "memory"); } } while (0)
    unsigned short vr[8];
#define GLA_VLOAD(rb) do { _Pragma("unroll") for (int jj = 0; jj < 8; ++jj) vr[jj] = U[(size_t)((rb) + 8 * (tid >> 6) + jj) * NU + UC_V + h * DV + vs * GVS + (tid & 63)]; } while (0)
    GLA_DMA(img0, 0, GIMG_A);
    GLA_VLOAD(b * TP);
    for (int c = 0; c < NCHUNK; ++c) {
        const int rbase = b * TP + c * GC, nvalid = (TP - c * GC) < GC ? (TP - c * GC) : GC;
        const unsigned char* img = img0 + (size_t)c * GIMG_BYTES;
        asm volatile("s_waitcnt vmcnt(8)" ::: "memory"); __syncthreads();
        GLA_DMA(img, GIMG_A, GIMG_B);
        { const int v = tid & 63, toct = tid >> 6; v4u o; const bool ok = 8 * toct < nvalid;
            o.x = (unsigned)vr[0] | ((unsigned)vr[1] << 16); o.y = (unsigned)vr[2] | ((unsigned)vr[3] << 16); o.z = (unsigned)vr[4] | ((unsigned)vr[5] << 16); o.w = (unsigned)vr[6] | ((unsigned)vr[7] << 16);
            if (!ok) o = (v4u){0u, 0u, 0u, 0u};
            *(LAS v4u*)(Vt + v * VT_LD + 8 * toct) = o; }
        GLA_VLOAD(rbase + GC);
        const int ti = w >> 1, vb = 2 * (w & 1);
        f32x4 oacc0 = (f32x4){0.f, 0.f, 0.f, 0.f}, oacc1 = oacc0;
        { const LAS bf16* qrow = Qt + (16 * ti + r16) * QT_LD + 8 * g4; const LAS bf16* s0row = St + (16 * vb + r16) * ST_LD + 8 * g4; const LAS bf16* s1row = s0row + 16 * ST_LD;
#pragma unroll
          for (int ks = 0; ks < 8; ++ks) { const bf16x8v qf = *(const LAS bf16x8v*)(qrow + 32 * ks);
              oacc0 = mfma16(qf, *(const LAS bf16x8v*)(s0row + 32 * ks), oacc0); oacc1 = mfma16(qf, *(const LAS bf16x8v*)(s1row + 32 * ks), oacc1); } }
        asm volatile("s_waitcnt vmcnt(8)" ::: "memory"); __syncthreads();
        if (c + 1 < NCHUNK) GLA_DMA(img + GIMG_BYTES, 0, GIMG_A);
        { const LAS bf16* arow = As + (16 * ti + r16) * AS_LD + 8 * g4; const LAS bf16* v0row = Vt + (16 * vb + r16) * VT_LD + 8 * g4; const LAS bf16* v1row = v0row + 16 * VT_LD;
#pragma unroll
          for (int ks = 0; ks < 2; ++ks) { const bf16x8v af = *(const LAS bf16x8v*)(arow + 32 * ks); oacc0 = mfma16(af, *(const LAS bf16x8v*)(v0row + 32 * ks), oacc0); oacc1 = mfma16(af, *(const LAS bf16x8v*)(v1row + 32 * ks), oacc1); }
          bf16* op = OY + (size_t)(rbase + 16 * ti + 4 * g4) * D + h * DV + vs * GVS + 16 * vb + r16;
          bf16* dump = (bf16*)(ws + WS_HB) + (size_t)tid * 64;
#pragma unroll
          for (int e = 0; e < 4; ++e) { bf16* p = (16 * ti + 4 * g4 + e < nvalid) ? op + (size_t)e * D : dump; p[0] = (bf16)f2bf(oacc0[e]); p[16] = (bf16)f2bf(oacc1[e]); } }
        bf16x8v vf[4][2];
#pragma unroll
        for (int j = 0; j < 4; ++j)
#pragma unroll
            for (int ks = 0; ks < 2; ++ks) vf[j][ks] = *(const LAS bf16x8v*)(Vt + (16 * j + r16) * VT_LD + 8 * g4 + 32 * ks);
#pragma unroll
        for (int i = 0; i < 2; ++i) { const int kt = 2 * w + i; const LAS bf16* krow = KHt + (16 * kt + r16) * KH_LD + 8 * g4; const f32x4 dl = *(const LAS f32x4*)(DL + 16 * kt + 4 * g4);
            const bf16x8v kf0 = *(const LAS bf16x8v*)(krow), kf1 = *(const LAS bf16x8v*)(krow + 32);
#pragma unroll
            for (int j = 0; j < 4; ++j) { f32x4 a = S[i][j];
                a = mfma16(kf0, vf[j][0], a); a = mfma16(kf1, vf[j][1], a);
                a = a * dl; S[i][j] = a;
                pg8::u32x2 o; o.x = pk2(a.x, a.y); o.y = pk2(a.z, a.w);
                *(LAS pg8::u32x2*)(St + (16 * j + r16) * ST_LD + 16 * kt + 4 * g4) = o; } }
    }
#undef GLA_DMA
#undef GLA_VLOAD
    asm volatile("s_waitcnt vmcnt(0)" ::: "memory");
    float* So = A.out + O_GP + ((size_t)(b * GH + h) * DK) * DV + vs * GVS;
#pragma unroll
    for (int i = 0; i < 2; ++i)
#pragma unroll
        for (int j = 0; j < 4; ++j)
#pragma unroll
            for (int e = 0; e < 4; ++e) So[(size_t)(16 * (2 * w + i) + 4 * g4 + e) * DV + 16 * j + r16] = S[i][j][e];
    __syncthreads();
}
constexpr int SC_LD = 136, SX_LD = 72;
constexpr int SL_CM = 0, SL_BM = SL_CM + 64 * SC_LD * 2, SL_BT = SL_BM + 64 * SC_LD * 2, SL_XT = SL_BT + 128 * SX_LD * 2, SL_XH = SL_XT + 64 * SX_LD * 2, SL_WS = SL_XH + 64 * SX_LD * 2, SL_HT = SL_WS + 64 * SX_LD * 2,
              SL_SM = SL_HT + 64 * SC_LD * 2, SL_END = SL_SM + 2 * 4 * 64 * 4;
static_assert(SL_END <= LDSCTL_OFF, "SSD LDS map");
__device__ __forceinline__ void ssd_prompt_unit(const Args& A, LAS unsigned char* lds, int tid, int lane, int w, int b, int head) {
    unsigned char* ws = A.ws;
    const bf16* XC = (const bf16*)(ws + WS_XC); const float* DTA = (const float*)(ws + WS_DTA); bf16* OY = (bf16*)(ws + WS_OY);
    LAS bf16* Cm = (LAS bf16*)(lds + SL_CM); LAS bf16* Bm = (LAS bf16*)(lds + SL_BM); LAS bf16* Bt = (LAS bf16*)(lds + SL_BT); LAS bf16* Xt = (LAS bf16*)(lds + SL_XT); LAS bf16* Xh = (LAS bf16*)(lds + SL_XH);
    LAS bf16* Ws = (LAS bf16*)(lds + SL_WS); LAS bf16* Ht = (LAS bf16*)(lds + SL_HT); LAS float* SM = (LAS float*)(lds + SL_SM);
    const int g = head >> 2, r16 = lane & 15, g4 = lane >> 4;
    const float dskip = A.in[14][head];
    f32x4 H[4];
#pragma unroll
    for (int j = 0; j < 4; ++j) H[j] = (f32x4){0.f, 0.f, 0.f, 0.f};
    for (int i = tid; i < 64 * SC_LD / 2; i += 512) ((LAS unsigned*)Ht)[i] = 0u;
    const int noct = tid & 15, trow = tid >> 4, xp = tid & 63, xso = tid >> 6;
    v4u cr[2], br[2]; unsigned short xr[8];
#define SSD2_LOAD(rb) do { _Pragma("unroll") for (int i = 0; i < 2; ++i) { const bf16* xrow = XC + (size_t)((rb) + trow + 32 * i) * CONV_DIM + SW + g * NS + 8 * noct; \
            br[i] = *(const v4u*)xrow; cr[i] = *(const v4u*)(xrow + SG * NS); } \
        _Pragma("unroll") for (int jj = 0; jj < 8; ++jj) xr[jj] = XC[(size_t)((rb) + 8 * xso + jj) * CONV_DIM + head * HD + xp]; } while (0)
    float s_lc = 0.f, s_dt = 0.f, s_rt[4] = {0.f, 0.f, 0.f, 0.f};
#define SSD2_SCLD(rb) do { if (tid < 64) { const float* dr = DTA + (size_t)(rb) * 64; s_lc = dr[(size_t)tid * 64 + 32 + head]; s_dt = dr[(size_t)tid * 64 + head]; \
            _Pragma("unroll") for (int r = 0; r < 4; ++r) s_rt[r] = dr[(size_t)(16 * r + 15) * 64 + 32 + head]; } } while (0)
#define SSD2_SCST(nv, par) do { if (tid < 64) { const int t = tid; float tot = 0.f, pre = 0.f; \
            _Pragma("unroll") for (int r = 0; r < 4; ++r) { if (16 * (r + 1) <= (nv)) { tot += s_rt[r]; if (r < (t >> 4)) pre += s_rt[r]; } } \
            const bool ok = t < (nv); const float cum = ok ? s_lc + pre : tot, dt = ok ? s_dt : 0.f; \
            LAS float* smw = SM + (par) * 256; smw[t] = cum; smw[64 + t] = dt; smw[128 + t] = __expf(tot - cum) * dt; if (t == 0) smw[192] = __expf(tot); } } while (0)
    SSD2_LOAD(b * TP);
    SSD2_SCLD(b * TP); SSD2_SCST((TP < GC ? TP : GC), 0);
    __syncthreads();
    int par = 0;
    for (int c0 = 0; c0 < TP; c0 += GC, par ^= 1) {
        const int rbase = b * TP + c0, nvalid = (TP - c0) < GC ? (TP - c0) : GC;
        const LAS float* sm = SM + par * 256;
#pragma unroll
        for (int i = 0; i < 2; ++i) { const int t = trow + 32 * i; v4u co = cr[i], bo = br[i];
            if (t >= nvalid) { co = (v4u){0u, 0u, 0u, 0u}; bo = co; }
            *(LAS v4u*)(Cm + t * SC_LD + 8 * noct) = co; *(LAS v4u*)(Bm + t * SC_LD + 8 * noct) = bo; }
        { const f32x4 w0 = *(const LAS f32x4*)(sm + 128 + 8 * xso), w1 = *(const LAS f32x4*)(sm + 128 + 8 * xso + 4); const bool ok = 8 * xso < nvalid; v4u xo, ho;
          xo.x = (unsigned)xr[0] | ((unsigned)xr[1] << 16); xo.y = (unsigned)xr[2] | ((unsigned)xr[3] << 16); xo.z = (unsigned)xr[4] | ((unsigned)xr[5] << 16); xo.w = (unsigned)xr[6] | ((unsigned)xr[7] << 16);
          ho.x = pk2(bf_lo(xo.x) * w0.x, bf_hi(xo.x) * w0.y); ho.y = pk2(bf_lo(xo.y) * w0.z, bf_hi(xo.y) * w0.w); ho.z = pk2(bf_lo(xo.z) * w1.x, bf_hi(xo.z) * w1.y); ho.w = pk2(bf_lo(xo.w) * w1.z, bf_hi(xo.w) * w1.w);
          if (!ok) { xo = (v4u){0u, 0u, 0u, 0u}; ho = xo; }
          *(LAS v4u*)(Xt + xp * SX_LD + 8 * xso) = xo; *(LAS v4u*)(Xh + xp * SX_LD + 8 * xso) = ho; }
        __syncthreads();
        SSD2_LOAD(rbase + GC); SSD2_SCLD(rbase + GC);
#pragma unroll
        for (int i = 0; i < 2; ++i) { const int idx = tid + 512 * i, n = idx & 127, soct = idx >> 7; unsigned short e[8];
#pragma unroll
            for (int jj = 0; jj < 8; ++jj) e[jj] = Bm[(8 * soct + jj) * SC_LD + n];
            v4u o; o.x = (unsigned)e[0] | ((unsigned)e[1] << 16); o.y = (unsigned)e[2] | ((unsigned)e[3] << 16); o.z = (unsigned)e[4] | ((unsigned)e[5] << 16); o.w = (unsigned)e[6] | ((unsigned)e[7] << 16);
            *(LAS v4u*)(Bt + n * SX_LD + 8 * soct) = o; }
        const int ti = w >> 1, sb = 2 * (w & 1);
        f32x4 sc0 = (f32x4){0.f, 0.f, 0.f, 0.f}, sc1 = sc0, y0 = sc0, y1 = sc0;
        { const LAS bf16* crow = Cm + (16 * ti + r16) * SC_LD + 8 * g4; const LAS bf16* b0row = Bm + (16 * sb + r16) * SC_LD + 8 * g4; const LAS bf16* b1row = b0row + 16 * SC_LD;
          const LAS bf16* h0row = Ht + (16 * sb + r16) * SC_LD + 8 * g4; const LAS bf16* h1row = h0row + 16 * SC_LD;
#pragma unroll
          for (int ks = 0; ks < 4; ++ks) { const bf16x8v cf = *(const LAS bf16x8v*)(crow + 32 * ks);
              if (sb <= ti) sc0 = mfma16(*(const LAS bf16x8v*)(b0row + 32 * ks), cf, sc0);
              if (sb + 1 <= ti) sc1 = mfma16(*(const LAS bf16x8v*)(b1row + 32 * ks), cf, sc1);
              y0 = mfma16(cf, *(const LAS bf16x8v*)(h0row + 32 * ks), y0); y1 = mfma16(cf, *(const LAS bf16x8v*)(h1row + 32 * ks), y1); } }
        { const int t = 16 * ti + r16; const float cumt = sm[t];
#pragma unroll
          for (int q = 0; q < 2; ++q) { const int s0 = 16 * (sb + q) + 4 * g4; const f32x4 d = q ? sc1 : sc0; const f32x4 cs = *(const LAS f32x4*)(sm + s0), ds = *(const LAS f32x4*)(sm + 64 + s0);
              float wv[4];
#pragma unroll
              for (int e = 0; e < 4; ++e) { const int s = s0 + e; float v = (s <= t) ? d[e] * __expf(cumt - cs[e]) * ds[e] : 0.f; if (s == t) v += dskip; wv[e] = v; }
              pg8::u32x2 o; o.x = pk2(wv[0], wv[1]); o.y = pk2(wv[2], wv[3]);
              *(LAS pg8::u32x2*)(Ws + t * SX_LD + s0) = o; } }
        { const f32x4 ec = *(const LAS f32x4*)(sm + 16 * ti + 4 * g4);
#pragma unroll
          for (int e = 0; e < 4; ++e) { const float s = __expf(ec[e]); y0[e] *= s; y1[e] *= s; } }
        __syncthreads();
        { const LAS bf16* wrow = Ws + (16 * ti + r16) * SX_LD + 8 * g4; const LAS bf16* x0row = Xt + (16 * sb + r16) * SX_LD + 8 * g4; const LAS bf16* x1row = x0row + 16 * SX_LD;
#pragma unroll
          for (int ks = 0; ks < 2; ++ks) { const bf16x8v wf = *(const LAS bf16x8v*)(wrow + 32 * ks); y0 = mfma16(wf, *(const LAS bf16x8v*)(x0row + 32 * ks), y0); y1 = mfma16(wf, *(const LAS bf16x8v*)(x1row + 32 * ks), y1); }
          bf16* op = OY + (size_t)(rbase + 16 * ti + 4 * g4) * D + GW + head * HD + 16 * sb + r16;
          bf16* dump = (bf16*)(ws + WS_HB) + (size_t)tid * 64;
#pragma unroll
          for (int e = 0; e < 4; ++e) { bf16* p = (16 * ti + 4 * g4 + e < nvalid) ? op + (size_t)e * D : dump; p[0] = (bf16)f2bf(y0[e]); p[16] = (bf16)f2bf(y1[e]); } }
        { const float dl = sm[192]; const LAS bf16* brow = Bt + (16 * w + r16) * SX_LD + 8 * g4;
          const bf16x8v bf0 = *(const LAS bf16x8v*)(brow), bf1 = *(const LAS bf16x8v*)(brow + 32);
#pragma unroll
          for (int j = 0; j < 4; ++j) { const LAS bf16* xrow = Xh + (16 * j + r16) * SX_LD + 8 * g4; f32x4 a = H[j] * dl;
              a = mfma16(bf0, *(const LAS bf16x8v*)(xrow), a); a = mfma16(bf1, *(const LAS bf16x8v*)(xrow + 32), a); H[j] = a;
              pg8::u32x2 o; o.x = pk2_sw(a.x, a.y); o.y = pk2_sw(a.z, a.w);
              *(LAS pg8::u32x2*)(Ht + (16 * j + r16) * SC_LD + 16 * w + 4 * g4) = o; } }
        SSD2_SCST(((TP - c0 - GC) < GC ? (TP - c0 - GC) : GC), par ^ 1);
        __syncthreads();
    }
#undef SSD2_LOAD
#undef SSD2_SCLD
#undef SSD2_SCST
    float* Ho = A.out + O_SP + ((size_t)(b * SH + head) * HD) * NS;
#pragma unroll
    for (int j = 0; j < 4; ++j) *(f32x4*)(Ho + (size_t)(16 * j + r16) * NS + 16 * w + 4 * g4) = H[j];
    __syncthreads();
}
__device__ __forceinline__ void gla_sample_unit(const Args& A, LAS unsigned char* lds, int tid, int lane, int w, int s, int h) {
    unsigned char* ws = A.ws;
    const bf16* U = (const bf16*)(ws + WS_U); const float* EG = (const float*)(ws + WS_EG); bf16* OY = (bf16*)(ws + WS_OY);
    LAS f32x4* Gs = (LAS f32x4*)(lds + RING_OFF); LAS float* Vs = (LAS float*)(lds + RING_OFF + 16384); LAS float* Red = (LAS float*)(lds + RING_OFF + 24576);
    const int rb = MPROMPT + 4 * s;
#pragma unroll
    for (int i = 0; i < 2; ++i) { const int idx = tid + 512 * i, t = idx >> 8, k = idx & 255; const bf16* up = U + (size_t)(rb + t) * NU + h * DK + k;
        Gs[idx] = (f32x4){EG[(size_t)(rb + t) * QK + h * DK + k], __uint_as_float((unsigned)up[UC_K] << 16), __uint_as_float((unsigned)up[UC_Q] << 16) * 0.0625f, 0.f}; }
#pragma unroll
    for (int i = 0; i < 4; ++i) { const int idx = tid + 512 * i, t = idx >> 9, v = idx & 511; Vs[idx] = __uint_as_float((unsigned)U[(size_t)(rb + t) * NU + UC_V + h * DV + v] << 16); }
    __syncthreads();
    f32x4 vr[4][2], acc[4][2];
#pragma unroll
    for (int t = 0; t < 4; ++t) { vr[t][0] = *(const LAS f32x4*)(Vs + t * 512 + 4 * lane); vr[t][1] = *(const LAS f32x4*)(Vs + t * 512 + 256 + 4 * lane); acc[t][0] = (f32x4){0.f, 0.f, 0.f, 0.f}; acc[t][1] = (f32x4){0.f, 0.f, 0.f, 0.f}; }
    const float* Sin = A.in[2] + ((size_t)(s * GH + h) * DK + 32 * w) * DV + 4 * lane; float* Sout = A.out + O_GS + ((size_t)(s * GH + h) * DK + 32 * w) * DV + 4 * lane;
    constexpr int SRB = 4;
    f32x4 cur[SRB][2], nxt[SRB][2], nx2[SRB][2];
#pragma unroll
    for (int u = 0; u < SRB; ++u) { cur[u][0] = *(const f32x4*)(Sin + (size_t)u * DV); cur[u][1] = *(const f32x4*)(Sin + (size_t)u * DV + 256);
                                    nxt[u][0] = *(const f32x4*)(Sin + (size_t)(SRB + u) * DV); nxt[u][1] = *(const f32x4*)(Sin + (size_t)(SRB + u) * DV + 256); }
    for (int kb = 0; kb < 32; kb += SRB) {
        const int kn = (kb + 2 * SRB < 32) ? kb + 2 * SRB : kb;
#pragma unroll
        for (int u = 0; u < SRB; ++u) { nx2[u][0] = *(const f32x4*)(Sin + (size_t)(kn + u) * DV); nx2[u][1] = *(const f32x4*)(Sin + (size_t)(kn + u) * DV + 256); }
#pragma unroll
        for (int u = 0; u < SRB; ++u) { const int k = 32 * w + kb + u;
#pragma unroll
            for (int t = 0; t < 4; ++t) { const f32x4 g4 = Gs[t * 256 + k];
                cur[u][0] = cur[u][0] * g4.x + vr[t][0] * g4.y; cur[u][1] = cur[u][1] * g4.x + vr[t][1] * g4.y;
                acc[t][0] = acc[t][0] + cur[u][0] * g4.z; acc[t][1] = acc[t][1] + cur[u][1] * g4.z; }
            float* q = Sout + (size_t)(kb + u) * DV; *(f32x4*)q = cur[u][0]; *(f32x4*)(q + 256) = cur[u][1]; }
#pragma unroll
        for (int u = 0; u < SRB; ++u) { cur[u][0] = nxt[u][0]; cur[u][1] = nxt[u][1]; nxt[u][0] = nx2[u][0]; nxt[u][1] = nx2[u][1]; }
    }
#pragma unroll
    for (int t = 0; t < 4; ++t) { *(LAS f32x4*)(Red + (w * 4 + t) * 512 + 4 * lane) = acc[t][0]; *(LAS f32x4*)(Red + (w * 4 + t) * 512 + 256 + 4 * lane) = acc[t][1]; }
    __syncthreads();
#pragma unroll
    for (int i = 0; i < 4; ++i) { const int idx = tid + 512 * i, t = idx >> 9, v = idx & 511; float o = 0.f;
#pragma unroll
        for (int ww = 0; ww < 8; ++ww) o += Red[(ww * 4 + t) * 512 + v];
        OY[(size_t)(rb + t) * D + h * DV + v] = (bf16)f2bf(o); }
    __syncthreads();
}
__device__ __forceinline__ void ssd_sample_unit(const Args& A, LAS unsigned char* lds, int tid, int lane, int w, int s, int j) {
    unsigned char* ws = A.ws;
    const bf16* XC = (const bf16*)(ws + WS_XC); const float* DTA = (const float*)(ws + WS_DTA); bf16* OY = (bf16*)(ws + WS_OY);
    LAS float* Bs = (LAS float*)(lds + RING_OFF); LAS float* Cs = Bs + 1024; LAS float* Xs = Cs + 1024; LAS float* DTs = Xs + 2048; LAS float* DAs = DTs + 32; LAS float* Ys = DAs + 32;
    const int rb = MPROMPT + 4 * s;
    if (tid < 128) { const int t = tid >> 5, c8 = tid & 31; const bf16* xr = XC + (size_t)(rb + t) * CONV_DIM; const v4u bw = *(const v4u*)(xr + SW + j * 256 + 8 * c8), cw = *(const v4u*)(xr + SW + SG * NS + j * 256 + 8 * c8);
        *(LAS f32x4*)(Bs + t * 256 + 8 * c8) = (f32x4){bf_lo(bw.x), bf_hi(bw.x), bf_lo(bw.y), bf_hi(bw.y)}; *(LAS f32x4*)(Bs + t * 256 + 8 * c8 + 4) = (f32x4){bf_lo(bw.z), bf_hi(bw.z), bf_lo(bw.w), bf_hi(bw.w)};
        *(LAS f32x4*)(Cs + t * 256 + 8 * c8) = (f32x4){bf_lo(cw.x), bf_hi(cw.x), bf_lo(cw.y), bf_hi(cw.y)}; *(LAS f32x4*)(Cs + t * 256 + 8 * c8 + 4) = (f32x4){bf_lo(cw.z), bf_hi(cw.z), bf_lo(cw.w), bf_hi(cw.w)}; }
    if (tid < 256) { const int t = tid >> 6, c8 = tid & 63; const v4u xw = *(const v4u*)(XC + (size_t)(rb + t) * CONV_DIM + j * 512 + 8 * c8);
        *(LAS f32x4*)(Xs + t * 512 + 8 * c8) = (f32x4){bf_lo(xw.x), bf_hi(xw.x), bf_lo(xw.y), bf_hi(xw.y)}; *(LAS f32x4*)(Xs + t * 512 + 8 * c8 + 4) = (f32x4){bf_lo(xw.z), bf_hi(xw.z), bf_lo(xw.w), bf_hi(xw.w)}; }
    if (tid < 32) { const int t = tid >> 3, hh = tid & 7; DTs[tid] = DTA[(size_t)(rb + t) * 64 + 8 * j + hh]; DAs[tid] = DTA[(size_t)(rb + t) * 64 + 32 + 8 * j + hh]; }
    __syncthreads();
    const int head = 8 * j + w, gl = w >> 2, pl = lane >> 5, nq = lane & 31;
    f32x4 B4[4], C4[4]; float dA[4], dt[4];
#pragma unroll
    for (int t = 0; t < 4; ++t) { B4[t] = *(const LAS f32x4*)(Bs + t * 256 + gl * 128 + 4 * nq); C4[t] = *(const LAS f32x4*)(Cs + t * 256 + gl * 128 + 4 * nq); dA[t] = DAs[t * 8 + w]; dt[t] = DTs[t * 8 + w]; }
    const float* Hin = A.in[3] + ((size_t)(s * SH + head) * HD) * NS + 4 * nq; float* Hout = A.out + O_SS + ((size_t)(s * SH + head) * HD) * NS + 4 * nq;
    const bool hi8 = (lane & 8) != 0;
    f32x4 h4[4], hn[4], hn2[4];
#pragma unroll
    for (int u = 0; u < 4; ++u) { h4[u] = *(const f32x4*)(Hin + (size_t)(2 * u + pl) * NS); hn[u] = *(const f32x4*)(Hin + (size_t)(2 * (4 + u) + pl) * NS); }
    for (int pb = 0; pb < 32; pb += 4) {
        const int pn = (pb + 8 < 32) ? pb + 8 : pb;
#pragma unroll
        for (int u = 0; u < 4; ++u) hn2[u] = *(const f32x4*)(Hin + (size_t)(2 * (pn + u) + pl) * NS);
#pragma unroll
        for (int u = 0; u < 4; ++u) { const int p = 2 * (pb + u) + pl; float y[4];
#pragma unroll
            for (int t = 0; t < 4; ++t) { const float dx = dt[t] * Xs[t * 512 + w * 64 + p]; h4[u] = h4[u] * dA[t] + B4[t] * dx; const f32x4 m = C4[t] * h4[u]; y[t] = (m.x + m.y) + (m.z + m.w); }
            *(f32x4*)(Hout + (size_t)p * NS) = h4[u];
            swap16(y[0], y[1]); const float s01 = y[0] + y[1];
            swap16(y[2], y[3]); const float s23 = y[2] + y[3];
            const float sn = hi8 ? s01 : s23; float kp = hi8 ? s23 : s01;
            kp += dppf<0x128>(sn); kp = half_row_allreduce(kp);
            if ((lane & 7) == 0) Ys[(((lane >> 3) & 1) * 2 + ((lane >> 4) & 1)) * 512 + w * 64 + p] = kp; }
#pragma unroll
        for (int u = 0; u < 4; ++u) { h4[u] = hn[u]; hn[u] = hn2[u]; }
    }
    __syncthreads();
#pragma unroll
    for (int i = 0; i < 4; ++i) { const int idx = tid + 512 * i, t = idx >> 9, c = idx & 511; OY[(size_t)(rb + t) * D + GW + j * 512 + c] = (bf16)f2bf(Ys[idx] + A.in[14][8 * j + (c >> 6)] * Xs[idx]); }
    __syncthreads();
}

#ifndef P3_NPRE
#define P3_NPRE 3
#endif
__device__ __forceinline__ void p3_mixers(const Args& args, LAS unsigned char* lds, int tid, int lane, int wave, int G, gu32* ctl, volatile LAS unsigned* MISC, int qword) {
    constexpr int NGLA = BATCH * GH * (DV / GVS), NSSD = BATCH * SH, NITEMS = 2 * DEC_B * 4;
    if ((int)blockIdx.x < NGLA) {
#pragma unroll 1
        for (int n = 0; n < P3_NPRE; ++n) {
            if (tid == 0) MISC[0] = __hip_atomic_fetch_add((unsigned*)(ctl + qword), 1u, __ATOMIC_RELAXED, __HIP_MEMORY_SCOPE_AGENT);
            __syncthreads(); const int it = (int)MISC[0]; __syncthreads();
            if (it >= NITEMS) break;
            if (it < DEC_B * 4) gla_sample_unit(args, lds, tid, opaque_lane(tid), wave, it >> 2, it & 3);
            else ssd_sample_unit(args, lds, tid, opaque_lane(tid), wave, (it - DEC_B * 4) >> 2, it & 3); } }
    for (int uu = blockIdx.x; uu < NGLA + NSSD; uu += G) {
        if (uu < NGLA) { const int u = uu, bh = (u & 7) + 8 * (u >> 6), vs = (u >> 3) & 7; gla_prompt_unit(args, lds, tid, opaque_lane(tid), wave, bh >> 2, bh & 3, vs); }
        else { const int u = uu - NGLA, q = u >> 3, bg = (u & 7) + 8 * (q >> 2); ssd_prompt_unit(args, lds, tid, opaque_lane(tid), wave, bg >> 3, 4 * (bg & 7) + (q & 3)); } }
    unsigned qnext = 0u; if (tid == 0) qnext = __hip_atomic_fetch_add((unsigned*)(ctl + qword), 1u, __ATOMIC_RELAXED, __HIP_MEMORY_SCOPE_AGENT);
    for (;;) {
        if (tid == 0) MISC[0] = qnext;
        __syncthreads(); const int it = (int)MISC[0]; __syncthreads();
        if (it >= NITEMS) break;
        if (tid == 0) qnext = __hip_atomic_fetch_add((unsigned*)(ctl + qword), 1u, __ATOMIC_RELAXED, __HIP_MEMORY_SCOPE_AGENT);
        if (it < DEC_B * 4) gla_sample_unit(args, lds, tid, opaque_lane(tid), wave, it >> 2, it & 3);
        else ssd_sample_unit(args, lds, tid, opaque_lane(tid), wave, (it - DEC_B * 4) >> 2, it & 3);
    }
}

__device__ __forceinline__ void p4_finalize(const Args& A, int lane, int wave, int G) {
    unsigned char* ws = A.ws;
    const bf16* U = (const bf16*)(ws + WS_U); const bf16* OY = (const bf16*)(ws + WS_OY); bf16* MIX = (bf16*)(ws + WS_MIX);
    const float* gnw = A.in[9]; const float* snw = A.in[15];
    const int gw = wave * G + blockIdx.x, NGW = G * NWAVES;
    const f32x4 w0 = *(const f32x4*)(gnw + 8 * lane), w1 = *(const f32x4*)(gnw + 8 * lane + 4);
    f32x4 wn[SG];
#pragma unroll
    for (int g = 0; g < SG; ++g) wn[g] = *(const f32x4*)(snw + g * 256 + 4 * lane);
#define P4_LOAD(ow_, rw_, yw_, zw_, rc_) do { const int rr_ = (rc_) < BATCH * SEQ ? ((rc_) / SEQ) * TP + NMETA + ((rc_) % SEQ) : (rc_) + BATCH * NMETA;     \
        const bf16* orow_ = OY + (size_t)rr_ * D; const bf16* ur_ = U + (size_t)rr_ * NU; \
        _Pragma("unroll") for (int h = 0; h < GH; ++h) { ow_[h] = *(const v4u*)(orow_ + h * DV + 8 * lane); rw_[h] = *(const v4u*)(ur_ + UC_R + h * DV + 8 * lane); } \
        _Pragma("unroll") for (int g = 0; g < SG; ++g) { yw_[g] = *(const pg8::u32x2*)(orow_ + GW + g * 256 + 4 * lane); zw_[g] = *(const pg8::u32x2*)(ur_ + UC_Z + g * 256 + 4 * lane); } } while (0)
    v4u ow[GH], rw[GH], own[GH], rwn[GH]; pg8::u32x2 yw[SG], zw[SG], ywn[SG], zwn[SG];
    if (gw < MC) P4_LOAD(ow, rw, yw, zw, gw);
    for (int rc = gw; rc < MC; rc += NGW) {
        bf16* mr = MIX + (size_t)rc * D;
        { const int rcn = rc + NGW < MC ? rc + NGW : rc; P4_LOAD(own, rwn, ywn, zwn, rcn); }
#pragma unroll
        for (int h = 0; h < GH; ++h) {
            const f32x4 o0 = (f32x4){bf_lo(ow[h].x), bf_hi(ow[h].x), bf_lo(ow[h].y), bf_hi(ow[h].y)}, o1 = (f32x4){bf_lo(ow[h].z), bf_hi(ow[h].z), bf_lo(ow[h].w), bf_hi(ow[h].w)};
            float ss = (o0.x * o0.x + o0.y * o0.y) + (o0.z * o0.z + o0.w * o0.w) + (o1.x * o1.x + o1.y * o1.y) + (o1.z * o1.z + o1.w * o1.w);
            ss = wave_sum(ss); const float rinv = 1.f / sqrtf(ss * (1.f / DV) + EPS);
            v4u m; m.x = pk2(o0.x * rinv * w0.x * silu_f(bf_lo(rw[h].x)), o0.y * rinv * w0.y * silu_f(bf_hi(rw[h].x))); m.y = pk2(o0.z * rinv * w0.z * silu_f(bf_lo(rw[h].y)), o0.w * rinv * w0.w * silu_f(bf_hi(rw[h].y)));
            m.z = pk2(o1.x * rinv * w1.x * silu_f(bf_lo(rw[h].z)), o1.y * rinv * w1.y * silu_f(bf_hi(rw[h].z))); m.w = pk2(o1.z * rinv * w1.z * silu_f(bf_lo(rw[h].w)), o1.w * rinv * w1.w * silu_f(bf_hi(rw[h].w)));
            *(GAS v4u*)(mr + h * DV + 8 * lane) = m;
        }
#pragma unroll
        for (int g = 0; g < SG; ++g) {
            const f32x4 y = (f32x4){bf_lo(yw[g].x), bf_hi(yw[g].x), bf_lo(yw[g].y), bf_hi(yw[g].y)};
            const f32x4 yz = (f32x4){y.x * silu_f(bf_lo(zw[g].x)), y.y * silu_f(bf_hi(zw[g].x)), y.z * silu_f(bf_lo(zw[g].y)), y.w * silu_f(bf_hi(zw[g].y))};
            float ss = (yz.x * yz.x + yz.y * yz.y) + (yz.z * yz.z + yz.w * yz.w);
            ss = wave_sum(ss); const float rinv = 1.f / sqrtf(ss * (1.f / 256.f) + EPS);
            pg8::u32x2 m; m.x = pk2(yz.x * rinv * wn[g].x, yz.y * rinv * wn[g].y); m.y = pk2(yz.z * rinv * wn[g].z, yz.w * rinv * wn[g].w);
            *(GAS pg8::u32x2*)(mr + GW + g * 256 + 4 * lane) = m;
        }
#pragma unroll
        for (int h = 0; h < GH; ++h) { ow[h] = own[h]; rw[h] = rwn[h]; }
#pragma unroll
        for (int g = 0; g < SG; ++g) { yw[g] = ywn[g]; zw[g] = zwn[g]; }
    }
#undef P4_LOAD
}
#define LN_LOAD(dst, rowptr) do { const GAS pg8::u32x2* xr_ = (const GAS pg8::u32x2*)(rowptr) + lane; _Pragma("unroll") for (int j_ = 0; j_ < 16; ++j_) dst[j_] = __builtin_nontemporal_load(xr_ + 64 * j_); } while (0)
template <bool OUT_BF16> __device__ __forceinline__ void ln_row(const pg8::u32x2 (&raw)[16], const LAS float* gam, const LAS float* bet, void* orow, int lane, const LAS int* tab, const bf16* slabs, int r, int nsl, int rem) {
    f32x4 v[16]; float s = 0.f;
    const int pm = r >> 8, rl = r & 255;
#pragma unroll
    for (int j = 0; j < 16; ++j) { const pg8::u32x2 xw = raw[j]; v[j] = (f32x4){bf_lo(xw.x), bf_hi(xw.x), bf_lo(xw.y), bf_hi(xw.y)}; const int ts = tab[pm * 16 + j];
        if (ts >= 0) { pg8::u32x2 sw[7];
#pragma unroll
            for (int q = 0; q < 7; ++q) { const int qq = q < nsl ? q : 0; sw[q] = __builtin_nontemporal_load((const GAS pg8::u32x2*)(slabs + (size_t)(ts + qq * rem) * 65536 + rl * 256) + lane); }
#pragma unroll
            for (int q = 0; q < 7; ++q) { const unsigned on = q < nsl ? 0xffffffffu : 0u; const unsigned sx = sw[q].x & on, sy = sw[q].y & on; v[j] = v[j] + (f32x4){bf_lo(sx), bf_hi(sx), bf_lo(sy), bf_hi(sy)}; }
            for (int q = 7; q < nsl; ++q) { const pg8::u32x2 sx = *((const GAS pg8::u32x2*)(slabs + (size_t)(ts + q * rem) * 65536 + rl * 256) + lane); v[j] = v[j] + (f32x4){bf_lo(sx.x), bf_hi(sx.x), bf_lo(sx.y), bf_hi(sx.y)}; } }
        s += (v[j].x + v[j].y) + (v[j].z + v[j].w); }
    const float mean = wave_sum(s) * (1.f / D); float s2 = 0.f;
#pragma unroll
    for (int j = 0; j < 16; ++j) { v[j] = v[j] - mean; s2 += (v[j].x * v[j].x + v[j].y * v[j].y) + (v[j].z * v[j].z + v[j].w * v[j].w); }
    const float rstd = 1.f / sqrtf(wave_sum(s2) * (1.f / D) + EPS);
#pragma unroll
    for (int j = 0; j < 16; ++j) { const f32x4 gm = *((const LAS f32x4*)gam + lane + 64 * j), bt = *((const LAS f32x4*)bet + lane + 64 * j); const f32x4 o = v[j] * rstd * gm + bt;
        if (OUT_BF16) ((GAS unsigned long long*)orow)[lane + 64 * j] = (unsigned long long)pk2(o.x, o.y) | ((unsigned long long)pk2(o.z, o.w) << 32);
        else __builtin_nontemporal_store(o, (f32x4*)orow + lane + 64 * j); }
}

#ifndef MK_PER_PHASE
#define MK_PER_PHASE 0
#endif
constexpr int NPHASE = 10;
__global__ void __launch_bounds__(NWAVES * 64, 2) hymba_fwd(Args args) {
    extern __shared__ __attribute__((aligned(16))) unsigned char lds_raw[];
    LAS unsigned char* lds = (LAS unsigned char*)lds_raw;
    volatile LAS unsigned* MISC = (volatile LAS unsigned*)(lds + MISC_OFF);
    const int tid = threadIdx.x, wave = __builtin_amdgcn_readfirstlane(tid >> 6), G = gridDim.x;
#define lane opaque_lane(tid)
    unsigned char* ws = args.ws;
    gu32* ctl = (gu32*)(ws + WS_CTL);
    for (int u = tid; u < (LDS_BYTES - LDSCTL_OFF) / 4; u += NWAVES * 64) ((LAS unsigned*)(lds + LDSCTL_OFF))[u] = 0u;
    __syncthreads();
    XcdBarrier bar; bar.bar = (unsigned*)(ctl + CW_BAR); bar.x = 0; bar.st = nullptr;
    if (!MK_PER_PHASE) bar = xcd_barrier_post((unsigned*)(ctl + CW_BAR), MISC + 8);
    const int lo = args.ph_lo, hi = args.ph_hi;
#define IN(k) (lo <= (k) && (k) < hi)
#define SEAM(k) do { if (IN(k) && IN((k) + 1)) xcd_barrier(bar); } while (0)

    bf16* WIN = (bf16*)(ws + WS_WIN); bf16* WOUT = (bf16*)(ws + WS_WOUT); bf16* WUP = (bf16*)(ws + WS_WUP); bf16* WDN = (bf16*)(ws + WS_WDN);
    bf16* XB = (bf16*)(ws + WS_XB); bf16* Ub = (bf16*)(ws + WS_U); float* UT = (float*)(ws + WS_UT); bf16* MIX = (bf16*)(ws + WS_MIX); bf16* HB = (bf16*)(ws + WS_HB); bf16* HID = (bf16*)(ws + WS_HID);
    bf16* PRE1 = (bf16*)(ws + WS_PRE1); bf16* PRE2 = (bf16*)(ws + WS_PRE2); bf16* SLABS = (bf16*)(ws + WS_SLAB);
    const pg8::RowMap rm{args.in[0], args.in[1], args.in[5], args.out + O_YP, TP, NMETA, SEQ, MPROMPT, MTOT, D};

    if (IN(0)) { p0_prologue(args, lds, tid, lane, wave, G); } SEAM(0);
    if (IN(1)) { const int nu1 = (MP / 256) * (NIN_PAD / 256), rounds1 = (nu1 + G - 1) / G, G1 = (nu1 + rounds1 - 1) / rounds1;
        if ((int)blockIdx.x < G1) { pg8::Gemm g{XB, WIN, MP, NIN_PAD, D}; pg8::StaticOrder S; S.init(MP, NIN_PAD, G1, (int)blockIdx.x);
            pg8::EpiInProj E{Ub, UT, NU, NU / 256};
            pg8::gemm_phase<pg8::EpiInProj, pg8::StaticOrder, true, true>(lds + RING_OFF, g, S, E); }
        convert_queue(args, lds, lane, wave, ctl + CW_CV0, 0); } SEAM(1);
    if (IN(2)) { p2_prepass(args, lds, tid, G, ctl, MISC); } SEAM(2);
    if (IN(3)) { p3_mixers(args, lds, tid, lane, wave, G, ctl, MISC, CW_Q);
    } SEAM(3);
    if (IN(4)) { p4_finalize(args, lane, wave, G); } SEAM(4);
    if (IN(5)) { pg8::Gemm g{MIX, WOUT, MC, D, D}; pg8::HybridOrder S; S.init(MC, D, D, G, (int)blockIdx.x);
        pg8::EpiResX E{rm, XB, PRE1, D, ALPHA, SLABS + (size_t)(S.rem ? S.slab_of((int)blockIdx.x / S.rem, (int)blockIdx.x % S.rem) : 0) * 65536};
        pg8::gemm_phase<pg8::EpiResX, pg8::HybridOrder, true, true>(lds + RING_OFF, g, S, E); } SEAM(5);
    if (IN(6)) { const int gw = wave * G + blockIdx.x, NGW = G * NWAVES;
        LAS int* tab = (LAS int*)(lds + RING_OFF); pg8::HybridOrder HS; HS.init(MC, D, D, G, 0);
        for (int i = tid; i < (MC / 256) * 16; i += NWAVES * 64) tab[i] = -1;
        LAS float* lgam = (LAS float*)(lds + RING_OFF + 4096); LAS float* lbet = lgam + D;
        for (int i = tid; i < D / 4; i += NWAVES * 64) { ((LAS f32x4*)lgam)[i] = ((const f32x4*)args.in[17])[i]; ((LAS f32x4*)lbet)[i] = ((const f32x4*)args.in[18])[i]; }
        __syncthreads(); for (int i = tid; i < HS.rem; i += NWAVES * 64) { pg8::Unit tu; HS.tail_unit(i, tu); tab[tu.pm * 16 + tu.pn] = i; } __syncthreads();
        if (gw < MC) { pg8::u32x2 raw[16], nraw[16]; LN_LOAD(raw, PRE1 + (size_t)gw * D);
            for (int r = gw; r < MC; r += NGW) { const int rn = r + NGW < MC ? r + NGW : r; LN_LOAD(nraw, PRE1 + (size_t)rn * D);
                ln_row<true>(raw, lgam, lbet, HB + (size_t)r * D, lane, tab, SLABS, r, HS.sp - 1, HS.rem);
#pragma unroll
                for (int j = 0; j < 16; ++j) raw[j] = nraw[j]; } } } SEAM(6);
    if (IN(7)) { const int nu7 = (MC / 256) * (DFF / 256), rounds7 = (nu7 + G - 1) / G, G7 = (nu7 + rounds7 - 1) / rounds7;
        if ((int)blockIdx.x < G7) { pg8::Gemm g{HB, WUP, MC, DFF, D}; pg8::StaticOrder S; S.init(MC, DFF, G7, (int)blockIdx.x);
            pg8::EpiRelu2 E{HID, DFF};
            pg8::gemm_phase<pg8::EpiRelu2, pg8::StaticOrder, true, true>(lds + RING_OFF, g, S, E); }
        if ((int)blockIdx.x < G7 || wave < 5) convert_queue(args, lds, lane, wave, ctl + CW_CV1, 1); } SEAM(7);
    if (IN(8)) { pg8::Gemm g{HID, WDN, MC, D, DFF}; pg8::HybridOrder S; S.init(MC, D, DFF, G, (int)blockIdx.x);
        pg8::EpiResH E{PRE2, HB, D, ALPHA, SLABS + (size_t)(S.rem ? S.slab_of((int)blockIdx.x / S.rem, (int)blockIdx.x % S.rem) : 0) * 65536};
        pg8::gemm_phase<pg8::EpiResH, pg8::HybridOrder, true, true>(lds + RING_OFF, g, S, E); } SEAM(8);
    if (IN(9)) { const int gw = wave * G + blockIdx.x, NGW = G * NWAVES;
        LAS int* tab = (LAS int*)(lds + RING_OFF); pg8::HybridOrder HS; HS.init(MC, D, DFF, G, 0);
        for (int i = tid; i < (MC / 256) * 16; i += NWAVES * 64) tab[i] = -1;
        LAS float* lgam = (LAS float*)(lds + RING_OFF + 4096); LAS float* lbet = lgam + D;
        for (int i = tid; i < D / 4; i += NWAVES * 64) { ((LAS f32x4*)lgam)[i] = ((const f32x4*)args.in[21])[i]; ((LAS f32x4*)lbet)[i] = ((const f32x4*)args.in[22])[i]; }
        __syncthreads(); for (int i = tid; i < HS.rem; i += NWAVES * 64) { pg8::Unit tu; HS.tail_unit(i, tu); tab[tu.pm * 16 + tu.pn] = i; } __syncthreads();
        if (gw < MC) { pg8::u32x2 raw[16], nraw[16]; LN_LOAD(raw, PRE2 + (size_t)gw * D);
            for (int r = gw; r < MC; r += NGW) { const int rn = r + NGW < MC ? r + NGW : r; LN_LOAD(nraw, PRE2 + (size_t)rn * D);
                ln_row<false>(raw, lgam, lbet, args.out + O_YP + (size_t)r * D, lane, tab, SLABS, r, HS.sp - 1, HS.rem);
#pragma unroll
                for (int j = 0; j < 16; ++j) raw[j] = nraw[j]; } } }
#undef IN
#undef SEAM
#undef lane
}

extern "C" void kernel_launch(void* const* d_in, const int* in_sizes, int n_in, void* d_out, int out_size, void* d_ws, size_t ws_size, hipStream_t stream) {
    static int grid = 0;
    if (grid == 0) {
        if (n_in != 23 || (size_t)out_size != O_END || ws_size < WS_END) { fprintf(stderr, "kernel_launch: shape mismatch: n_in %d out %d ws %zu (need 23, %zu, %zu)\n", n_in, out_size, ws_size, (size_t)O_END, (size_t)WS_END); grid = -1; return; }
        int dev = 0, cus = 0, per_cu = 0;
        if (hipGetDevice(&dev) != hipSuccess || hipDeviceGetAttribute(&cus, hipDeviceAttributeMultiprocessorCount, dev) != hipSuccess) { grid = -1; return; }
        if (hipFuncSetAttribute((const void*)hymba_fwd, hipFuncAttributeMaxDynamicSharedMemorySize, LDS_BYTES) != hipSuccess) { fprintf(stderr, "kernel_launch: hipFuncSetAttribute failed\n"); grid = -1; return; }
        if (hipOccupancyMaxActiveBlocksPerMultiprocessor(&per_cu, (const void*)hymba_fwd, NWAVES * 64, LDS_BYTES) != hipSuccess || per_cu < 1) { fprintf(stderr, "kernel_launch: occupancy query reports %d blocks per CU\n", per_cu); }
        (void)hipGetLastError();
        grid = cus;
    }
    if (grid < 0) return;
    (void)hipMemsetAsync((char*)d_ws + WS_CTL, 0, CTL_ZERO_BYTES, stream);
    Args a{};
    for (int i = 0; i < 23; ++i) a.in[i] = (const float*)d_in[i];
    a.out = (float*)d_out; a.ws = (unsigned char*)d_ws;
#if MK_PER_PHASE
    for (int p = 0; p < NPHASE; ++p) { a.ph_lo = p; a.ph_hi = p + 1; hipLaunchKernelGGL(hymba_fwd, dim3(grid), dim3(NWAVES * 64), LDS_BYTES, stream, a); }
#else
    a.ph_lo = 0; a.ph_hi = NPHASE;
    hipLaunchKernelGGL(hymba_fwd, dim3(grid), dim3(NWAVES * 64), LDS_BYTES, stream, a);
#endif
    const hipError_t le = hipPeekAtLastError();
    if (le != hipSuccess) fprintf(stderr, "kernel_launch: launch failed: %s\n", hipGetErrorName(le));
}
```
